# Optimizing an MI355X kernel written in HIP

```python
import jax, jax.numpy as jnp
from jax import lax
import numpy as np

D_MODEL = 1024
BATCH = 16
SEQ = 2048
DEPTH = 2
DEC_BATCH = 2
DEC_SEQ = 16384
PAST_LEN = 128

GRID_W = 64
HEAD_DIM = 64
EPS = 1e-6
NEG = -1e30
NA_HEADS = 8
NA_WIN_H = 8
NA_WIN_W = 16
WB_HEADS = 8
WB_KV_HEADS = 2
WB_WINDOW = 128
WB_BLOCK = 128
T5_BUCKETS = 32
T5_MAX_DIST = 128
MLA_HEADS = 16
MLA_Q_RANK = 256
MLA_KV_RANK = 128
MLA_NOPE = 64
MLA_ROPE = 32
MLA_V = 64
ROPE_THETA = 10000.0
MLA_QBLOCK = 128

NA_W = NA_HEADS * HEAD_DIM
WB_QW = WB_HEADS * HEAD_DIM
WB_KVW = WB_KV_HEADS * HEAD_DIM
EVEN_MIX = NA_W + WB_QW
EVEN_IN = 3 * NA_W + WB_QW + 2 * WB_KVW + EVEN_MIX
ODD_MIX = MLA_HEADS * MLA_V
ODD_IN = MLA_Q_RANK + MLA_KV_RANK + MLA_ROPE + ODD_MIX
N_EVEN = (DEPTH + 1) // 2
N_ODD = DEPTH // 2

kernel_name = "hybrid_natten_swa_mla_encoder"


def rms_norm(x, g):
    xf = x.astype(jnp.float32)
    y = xf * lax.rsqrt(jnp.mean(xf * xf, axis=-1, keepdims=True) + EPS)
    return (y * g.astype(jnp.float32)).astype(x.dtype)


def t5_bucket(rel):
    nb = T5_BUCKETS // 2
    ret = (rel > 0).astype(np.int32) * nb
    n = np.abs(rel)
    max_exact = nb // 2
    large = max_exact + (np.log(np.maximum(n, 1) / max_exact)
                         / np.log(T5_MAX_DIST / max_exact) * (nb - max_exact)).astype(np.int32)
    large = np.minimum(large, nb - 1)
    return ret + np.where(n < max_exact, n, large)


def neighbourhood_attention(q, k, v, rpb):
    b, l = q.shape[:2]
    rows = l // GRID_W
    kh = min(NA_WIN_H, rows)
    r = np.arange(rows)
    row_start = np.clip(r - kh // 2, 0, rows - kh)
    row_idx = row_start[:, None] + np.arange(kh)[None, :]
    c = np.arange(GRID_W)
    col_start = np.clip(c - NA_WIN_W // 2, 0, GRID_W - NA_WIN_W)
    col_ok = (c[None, :] >= col_start[:, None]) & (c[None, :] < col_start[:, None] + NA_WIN_W)
    d_row = row_idx - r[:, None]
    d_col = np.clip(c[None, :] - c[:, None], -(NA_WIN_W - 1), NA_WIN_W - 1)
    idx_r = (d_row + NA_WIN_H - 1)[:, None, :, None]
    idx_c = (d_col + NA_WIN_W - 1)[None, :, None, :]
    bias = rpb[:, idx_r, idx_c].astype(jnp.float32)
    bias = jnp.where(jnp.asarray(col_ok)[None, None, :, None, :], bias, NEG)

    qg = (q * (HEAD_DIM ** -0.5)).reshape(b, rows, GRID_W, NA_HEADS, HEAD_DIM)
    kg = k.reshape(b, rows, GRID_W, NA_HEADS, HEAD_DIM)[:, row_idx]
    vg = v.reshape(b, rows, GRID_W, NA_HEADS, HEAD_DIM)[:, row_idx]
    s = jnp.einsum('brqhd,brkwhd->bhrqkw', qg, kg).astype(jnp.float32) + bias[None]
    p = jax.nn.softmax(s.reshape(b, NA_HEADS, rows, GRID_W, kh * GRID_W), axis=-1)
    p = p.reshape(s.shape).astype(v.dtype)
    o = jnp.einsum('bhrqkw,brkwhd->brqhd', p, vg)
    return o.reshape(b, l, NA_W)


def window_gqa(q, k, v, sink, t5_bias):
    b, l = q.shape[:2]
    nblk = l // WB_BLOCK
    g = WB_HEADS // WB_KV_HEADS
    pad = ((0, 0), (WB_BLOCK, WB_BLOCK), (0, 0), (0, 0))

    def band(t):
        t = jnp.pad(t, pad).reshape(b, nblk + 2, WB_BLOCK, WB_KV_HEADS, HEAD_DIM)
        return jnp.concatenate([t[:, :-2], t[:, 1:-1], t[:, 2:]], axis=2)

    kb, vb = band(k), band(v)
    qb = (q * (HEAD_DIM ** -0.5)).reshape(b, nblk, WB_BLOCK, WB_KV_HEADS, g, HEAD_DIM)
    s = jnp.einsum('bnqhgd,bnkhd->bnhgqk', qb, kb).astype(jnp.float32)
    rel = (np.arange(3 * WB_BLOCK) - WB_BLOCK)[None, :] - np.arange(WB_BLOCK)[:, None]
    bias = t5_bias[t5_bucket(rel)].astype(jnp.float32)
    bias = bias.transpose(2, 0, 1).reshape(WB_KV_HEADS, g, WB_BLOCK, 3 * WB_BLOCK)
    kpos = np.arange(nblk)[:, None] * WB_BLOCK - WB_BLOCK + np.arange(3 * WB_BLOCK)[None, :]
    valid = (np.abs(rel) <= WB_WINDOW)[None] & ((kpos >= 0) & (kpos < l))[:, None, :]
    s = jnp.where(jnp.asarray(valid)[None, :, None, None], s + bias[None, None], NEG)
    sink_b = jnp.broadcast_to(sink.reshape(WB_KV_HEADS, g, 1, 1).astype(jnp.float32), s.shape[:-1] + (1,))
    p = jax.nn.softmax(jnp.concatenate([s, sink_b], axis=-1), axis=-1)[..., :-1].astype(v.dtype)
    o = jnp.einsum('bnhgqk,bnkhd->bnqhgd', p, vb)
    return o.reshape(b, l, WB_QW)


def rope_tables(l, dtype):
    inv_freq = 1.0 / (ROPE_THETA ** (jnp.arange(0, MLA_ROPE, 2, dtype=jnp.float32) / MLA_ROPE))
    ang = jnp.arange(l, dtype=jnp.float32)[:, None] * inv_freq[None, :]
    return jnp.cos(ang).astype(dtype), jnp.sin(ang).astype(dtype)


def apply_rope(x, cos, sin):
    x1, x2 = jnp.split(x, 2, axis=-1)
    return jnp.concatenate([x1 * cos - x2 * sin, x2 * cos + x1 * sin], axis=-1)


def mla(q_lat, kv_lat, k_rope, q_norm_g, w_qb, kv_norm_g, w_kvb):
    b, l = q_lat.shape[:2]
    q = (rms_norm(q_lat, q_norm_g) @ w_qb).reshape(b, l, MLA_HEADS, MLA_NOPE + MLA_ROPE)
    kv = (rms_norm(kv_lat, kv_norm_g) @ w_kvb).reshape(b, l, MLA_HEADS, MLA_NOPE + MLA_V)
    q_nope, q_pe = q[..., :MLA_NOPE], q[..., MLA_NOPE:]
    k_nope, v = kv[..., :MLA_NOPE], kv[..., MLA_NOPE:]
    cos, sin = rope_tables(l, q.dtype)
    q_pe = apply_rope(q_pe, cos[:, None, :], sin[:, None, :])
    k_pe = apply_rope(k_rope, cos, sin)
    scale = (MLA_NOPE + MLA_ROPE) ** -0.5
    nq = l // MLA_QBLOCK
    qn = (q_nope * scale).reshape(b, nq, MLA_QBLOCK, MLA_HEADS, MLA_NOPE).transpose(1, 0, 2, 3, 4)
    qp = (q_pe * scale).reshape(b, nq, MLA_QBLOCK, MLA_HEADS, MLA_ROPE).transpose(1, 0, 2, 3, 4)

    def block(args):
        qn_b, qp_b = args
        s = (jnp.einsum('bqhd,bkhd->bhqk', qn_b, k_nope)
             + jnp.einsum('bqhd,bkd->bhqk', qp_b, k_pe)).astype(jnp.float32)
        p = jax.nn.softmax(s, axis=-1).astype(v.dtype)
        return jnp.einsum('bhqk,bkhd->bqhd', p, v)

    o = lax.map(block, (qn, qp))
    return o.transpose(1, 0, 2, 3, 4).reshape(b, l, ODD_MIX)


def even_layer(h, w_in, w_out, rpb, sink, t5_bias):
    b, l, _ = h.shape
    u = h @ w_in
    qa, ka, va, qb, kb, vb, gate = jnp.split(
        u, [NA_W, 2 * NA_W, 3 * NA_W, 3 * NA_W + WB_QW, 3 * NA_W + WB_QW + WB_KVW,
            3 * NA_W + WB_QW + 2 * WB_KVW], axis=-1)
    oa = neighbourhood_attention(qa.reshape(b, l, NA_HEADS, HEAD_DIM), ka.reshape(b, l, NA_HEADS, HEAD_DIM),
                                 va.reshape(b, l, NA_HEADS, HEAD_DIM), rpb)
    ob = window_gqa(qb.reshape(b, l, WB_HEADS, HEAD_DIM), kb.reshape(b, l, WB_KV_HEADS, HEAD_DIM),
                    vb.reshape(b, l, WB_KV_HEADS, HEAD_DIM), sink, t5_bias)
    o = jnp.concatenate([oa, ob], axis=-1) * jax.nn.silu(gate)
    return o @ w_out


def odd_layer(h, w_in, q_norm_g, w_qb, kv_norm_g, w_kvb, w_out):
    u = h @ w_in
    q_lat, kv_lat, k_rope, gate = jnp.split(
        u, [MLA_Q_RANK, MLA_Q_RANK + MLA_KV_RANK, MLA_Q_RANK + MLA_KV_RANK + MLA_ROPE], axis=-1)
    o = mla(q_lat, kv_lat, k_rope, q_norm_g, w_qb, kv_norm_g, w_kvb) * jax.nn.silu(gate)
    return o @ w_out


def trunk(x, c, ada_w, ada_b, norm_g, t5_bias, ev_w_in, na_rpb, wb_sink, ev_w_out,
          mla_w_in, mla_q_norm, mla_w_qb, mla_kv_norm, mla_w_kvb, mla_w_out, final_g):
    cs = jax.nn.silu(c)
    for i in range(DEPTH):
        mod = (cs @ ada_w[i] + ada_b[i])[:, None, :]
        shift, scale, gate = jnp.split(mod, 3, axis=-1)
        h = rms_norm(x, norm_g[i]) * (1 + scale) + shift
        j = i // 2
        if i % 2 == 0:
            out = even_layer(h, ev_w_in[j], ev_w_out[j], na_rpb[j], wb_sink[j], t5_bias)
        else:
            out = odd_layer(h, mla_w_in[j], mla_q_norm[j], mla_w_qb[j], mla_kv_norm[j], mla_w_kvb[j], mla_w_out[j])
        x = x + gate * out
    return rms_norm(x, final_g)


def setup_inputs(seed: int = 0) -> dict:
    key = jax.random.key(seed)
    ks = jax.random.split(key, 21)
    D = D_MODEL

    def nrm(k, shape, s):
        return jax.random.normal(k, shape, jnp.float32) * s

    return {
        "x_prompt": nrm(ks[0], (BATCH, SEQ, D), 1.0),
        "x_sample": nrm(ks[1], (DEC_BATCH, DEC_SEQ, D), 1.0),
        "c_prompt": nrm(ks[2], (BATCH, D), 1.0),
        "c_sample": nrm(ks[3], (DEC_BATCH, D), 1.0),
        "ada_w": nrm(ks[4], (DEPTH, D, 3 * D), 0.5 * D ** -0.5),
        "ada_b": nrm(ks[5], (DEPTH, 3 * D), 0.02),
        "norm_g": 1.0 + nrm(ks[6], (DEPTH, D), 0.02),
        "t5_bias": nrm(ks[7], (T5_BUCKETS, WB_HEADS), 0.1),
        "ev_w_in": nrm(ks[8], (N_EVEN, D, EVEN_IN), D ** -0.5),
        "na_rpb": nrm(ks[9], (N_EVEN, NA_HEADS, 2 * NA_WIN_H - 1, 2 * NA_WIN_W - 1), 0.1),
        "wb_sink": nrm(ks[10], (N_EVEN, WB_HEADS), 0.5),
        "ev_w_out": nrm(ks[11], (N_EVEN, EVEN_MIX, D), EVEN_MIX ** -0.5),
        "mla_w_in": nrm(ks[12], (N_ODD, D, ODD_IN), D ** -0.5),
        "mla_q_norm": 1.0 + nrm(ks[13], (N_ODD, MLA_Q_RANK), 0.02),
        "mla_w_qb": nrm(ks[14], (N_ODD, MLA_Q_RANK, MLA_HEADS * (MLA_NOPE + MLA_ROPE)), MLA_Q_RANK ** -0.5),
        "mla_kv_norm": 1.0 + nrm(ks[15], (N_ODD, MLA_KV_RANK), 0.02),
        "mla_w_kvb": nrm(ks[16], (N_ODD, MLA_KV_RANK, MLA_HEADS * (MLA_NOPE + MLA_V)), MLA_KV_RANK ** -0.5),
        "mla_w_out": nrm(ks[17], (N_ODD, ODD_MIX, D), ODD_MIX ** -0.5),
        "final_g": 1.0 + nrm(ks[18], (D,), 0.02),
    }


def reference(x_prompt, x_sample, c_prompt, c_sample, ada_w, ada_b, norm_g, t5_bias, ev_w_in, na_rpb,
              wb_sink, ev_w_out, mla_w_in, mla_q_norm, mla_w_qb, mla_kv_norm, mla_w_kvb, mla_w_out, final_g):
    y_prompt = trunk(x_prompt, c_prompt, ada_w, ada_b, norm_g, t5_bias, ev_w_in, na_rpb, wb_sink, ev_w_out,
                     mla_w_in, mla_q_norm, mla_w_qb, mla_kv_norm, mla_w_kvb, mla_w_out, final_g)
    y_sample = trunk(x_sample, c_sample, ada_w, ada_b, norm_g, t5_bias, ev_w_in, na_rpb, wb_sink, ev_w_out,
                     mla_w_in, mla_q_norm, mla_w_qb, mla_kv_norm, mla_w_kvb, mla_w_out, final_g)
    return (y_prompt, y_sample)
```

```cpp
#include <hip/hip_runtime.h>
#include <hip/hip_cooperative_groups.h>
#include <cstdio>
#include <cstdint>
namespace cg = cooperative_groups;

#define LAS __attribute__((address_space(3)))
typedef unsigned short bf16_t;
typedef short bf16x8 __attribute__((ext_vector_type(8)));
typedef short s16x4 __attribute__((ext_vector_type(4)));
typedef float f32x4 __attribute__((ext_vector_type(4)));
typedef float f32x16 __attribute__((ext_vector_type(16)));
typedef unsigned u32x4 __attribute__((ext_vector_type(4)));
typedef unsigned u32x2 __attribute__((ext_vector_type(2)));

constexpr int DM = 1024, M_TOK = 65536, M_A = 32768;
constexpr int EV_IN = 3328, OD_IN = 1440, OD_INP = 1536;
constexpr float EPS = 1e-6f, LOG2E = 1.4426950408889634f;
constexpr float QS64 = 0.125f * LOG2E;
constexpr float QS96 = 0.10206207261596577f * LOG2E;

constexpr size_t MiB = 1u << 20;
constexpr size_t WS_SSQQ = 0, WS_SSQKV = 256 * 1024, WS_MOD = 512 * 1024, WS_ZERO_BYTES = MiB;
constexpr size_t WS_BAR = 960 * 1024;
constexpr size_t WS_ROPE = 1 * MiB;
constexpr size_t WS_KPE = 3 * MiB;
constexpr size_t WS_WIN0 = 7 * MiB;
constexpr size_t WS_WOUT0 = WS_WIN0 + (size_t)EV_IN * DM * 2;
constexpr size_t WS_WIN1 = WS_WOUT0 + (size_t)DM * DM * 2;
constexpr size_t WS_WQB = WS_WIN1 + (size_t)OD_INP * DM * 2;
constexpr size_t WS_WKVB = WS_WQB + (size_t)1536 * 256 * 2;
constexpr size_t WS_WOUT1 = WS_WKVB + (size_t)2048 * 128 * 2;
static_assert(WS_WOUT1 + (size_t)DM * DM * 2 <= 32 * MiB, "ws map");
constexpr size_t WS_U0 = 32 * MiB;
constexpr size_t WS_U1 = 32 * MiB;
constexpr size_t WS_H1 = 224 * MiB;
constexpr size_t WS_QG = 224 * MiB;
constexpr size_t WS_KG = 320 * MiB;
constexpr size_t WS_VG = 384 * MiB;
constexpr size_t WS_END = 448 * MiB;

constexpr int LDS_BYTES = 135168;

struct Params {
    const float *x_p, *x_s, *c_p, *c_s, *ada_w, *ada_b, *norm_g, *t5_bias, *ev_w_in, *na_rpb, *wb_sink, *ev_w_out,
                *mla_w_in, *mla_q_norm, *mla_w_qb, *mla_kv_norm, *mla_w_kvb, *mla_w_out, *final_g;
    float* out; unsigned char* ws;
};

__device__ __forceinline__ int batch_of_row(int m) { return m < M_A ? (m >> 11) : 16 + ((m - M_A) >> 14); }
__device__ __forceinline__ int pos_of_row(int m) { return m < M_A ? (m & 2047) : ((m - M_A) & 16383); }
__device__ __forceinline__ unsigned cvt_pk_bf16(float lo, float hi) { unsigned r; asm volatile("v_cvt_pk_bf16_f32 %0, %1, %2" : "=v"(r) : "v"(lo), "v"(hi)); return r; }
__device__ __forceinline__ bf16x8 pack8(const f32x16& p, int base) {
    u32x4 w = {cvt_pk_bf16(p[base + 0], p[base + 1]), cvt_pk_bf16(p[base + 2], p[base + 3]), cvt_pk_bf16(p[base + 4], p[base + 5]), cvt_pk_bf16(p[base + 6], p[base + 7])};
    return *reinterpret_cast<bf16x8*>(&w);
}
__device__ __forceinline__ float bf2f(bf16_t v) { return __uint_as_float((unsigned)v << 16); }
__device__ __forceinline__ float wave_sum(float v) {
#pragma unroll
    for (int o = 1; o < 64; o <<= 1) v += __shfl_xor(v, o);
    return v;
}
#define LDS_WAIT() asm volatile("s_waitcnt lgkmcnt(0)" ::: "memory")
__device__ __forceinline__ int opaque_tid() { int t = threadIdx.x; asm volatile("" : "+v"(t)); return t; }

__device__ const unsigned char T5_BUCKET[257] = {
15,15,15,15,15,15,15,15,15,15,15,15,15,15,15,15,15,15,15,15,15,15,15,15,15,15,15,15,15,15,15,15,15,15,15,15,15,15,14,14,14,14,14,14,14,14,14,14,14,14,14,14,14,14,14,14,14,14,14,14,14,14,14,14,14,13,13,13,13,13,13,13,13,13,13,13,13,13,13,13,13,13,13,12,12,12,12,12,12,12,12,12,12,12,12,12,12,11,11,11,11,11,11,11,11,11,10,10,10,10,10,10,10,9,9,9,9,8,8,8,8,7,6,5,4,3,2,1,0,17,18,19,20,21,22,23,24,24,24,24,25,25,25,25,26,26,26,26,26,26,26,27,27,27,27,27,27,27,27,27,28,28,28,28,28,28,28,28,28,28,28,28,28,28,29,29,29,29,29,29,29,29,29,29,29,29,29,29,29,29,29,29,30,30,30,30,30,30,30,30,30,30,30,30,30,30,30,30,30,30,30,30,30,30,30,30,30,30,30,31,31,31,31,31,31,31,31,31,31,31,31,31,31,31,31,31,31,31,31,31,31,31,31,31,31,31,31,31,31,31,31,31,31,31,31,31,31};

#define XB_TMO      128
#define XB_XCNT(j)  (256  + 64 * (j))
#define XB_XSUB(j)  (1280 + 64 * (j))
#define XB_XGEN(j)  (2304 + 64 * (j))
#define XB_TOP      3328
#define XB_TOPGEN   3392
#define XCD_BAR_WORDS 3456
#define XB_SPIN_CAP (1u << 18)

__device__ __forceinline__ unsigned xb_ld(unsigned* p)              { return __hip_atomic_load(p, __ATOMIC_RELAXED, __HIP_MEMORY_SCOPE_AGENT); }
__device__ __forceinline__ unsigned xb_add(unsigned* p, unsigned v) { return __hip_atomic_fetch_add(p, v, __ATOMIC_RELAXED, __HIP_MEMORY_SCOPE_AGENT); }
__device__ __forceinline__ unsigned xb_xcc_id() { return (unsigned)__builtin_amdgcn_s_getreg((3 << 11) | 20) & 0xFu; }
#define XB_SPIN(cond, bar) do { unsigned _sp = 0; while (cond) { __builtin_amdgcn_s_sleep(1); \
    if ((++_sp & 255u) == 0u) { if (xb_ld(&(bar)[XB_TMO])) break; if (_sp > XB_SPIN_CAP) { atomicAdd(&(bar)[XB_TMO], 1u); break; } } } } while (0)

struct XcdBarrier {
    unsigned* bar; unsigned x;
    volatile LAS unsigned* st;
};

__device__ __forceinline__ XcdBarrier xcd_barrier_post(unsigned* bar, volatile LAS unsigned* st) {
    XcdBarrier b; b.bar = bar; b.x = xb_xcc_id(); b.st = st;
    if (threadIdx.x == 0) (void)xb_add(&bar[XB_XCNT(b.x)], 1u);
    return b;
}
__device__ __forceinline__ void xcd_barrier_complete(unsigned* bar, unsigned x, unsigned& nloc, unsigned& nx) {
    const unsigned G = gridDim.x * gridDim.y * gridDim.z;
    unsigned sum, cnt, mine, sp = 0u;
    for (;;) {
        sum = 0u; cnt = 0u; mine = 0u;
#pragma unroll
        for (unsigned j = 0; j < 16; ++j) { const unsigned c = xb_ld(&bar[XB_XCNT(j)]); sum += c; cnt += (c > 0u) ? 1u : 0u; mine = (j == x) ? c : mine; }
        if (sum == G) break;
        __builtin_amdgcn_s_sleep(1);
        if ((++sp & 255u) == 0u) { if (xb_ld(&bar[XB_TMO])) break; if (sp > XB_SPIN_CAP) { atomicAdd(&bar[XB_TMO], 1u); break; } }
    }
    nloc = mine > 0u ? mine : 1u; nx = cnt > 0u ? cnt : 1u;
}

__device__ __forceinline__ void xcd_barrier(const XcdBarrier& b) {
    asm volatile("s_waitcnt vmcnt(0)" ::: "memory");
    __syncthreads();
    if (threadIdx.x == 0) {
        unsigned* bar = b.bar;
        __builtin_amdgcn_s_waitcnt(0);
        unsigned nloc = b.st[0], nx = b.st[1];
        if (nloc == 0u) { xcd_barrier_complete(bar, b.x, nloc, nx); b.st[0] = nloc; b.st[1] = nx; }
        const unsigned old = xb_add(&bar[XB_XSUB(b.x)], 1u);
        const unsigned gen = old / nloc;
        if (old + 1u == (gen + 1u) * nloc) {
            __builtin_amdgcn_fence(__ATOMIC_RELEASE, "agent");
            asm volatile("s_waitcnt vmcnt(0)" ::: "memory");
            const unsigned og = xb_add(&bar[XB_TOP], 1u);
            const unsigned tg = og / nx;
            if (og + 1u == (tg + 1u) * nx) xb_add(&bar[XB_TOPGEN], 1u);
            else XB_SPIN(xb_ld(&bar[XB_TOPGEN]) == tg, bar);
            __builtin_amdgcn_fence(__ATOMIC_ACQUIRE, "agent");
            xb_add(&bar[XB_XGEN(b.x)], 1u);
            asm volatile("s_waitcnt vmcnt(0)" ::: "memory");
        } else {
            XB_SPIN(xb_ld(&bar[XB_XGEN(b.x)]) == gen, bar);
            __builtin_amdgcn_fence(__ATOMIC_ACQUIRE, "agent");
            asm volatile("s_waitcnt vmcnt(0)" ::: "memory");
        }
    }
    __syncthreads();
}

namespace pg8 {
constexpr int BM = 256, BK = 64, HALF = 128, HTB = HALF * BK * 2, STAGE_BYTES = 8 * HTB, NXCD = 8, WGM = 8;
__host__ __device__ __forceinline__ int lds_byte(int r, int c) { const int st = (r >> 4) * 2 + (c >> 5), rr = r & 15, cc = c & 31, ob = rr * 64 + cc * 2; return st * 1024 + (ob ^ (((ob >> 9) & 1) << 5)); }
__host__ __device__ __forceinline__ void stage_rc(int b, int& R, int& C) { const int st = b / 1024, sb = b % 1024, swz = sb ^ (((sb >> 9) & 1) << 5); R = (st >> 1) * 16 + swz / 64; C = (st & 1) * 32 + (swz % 64) / 2; }
__host__ __device__ __forceinline__ int perm32(int rho) { const int n = rho >> 4, i = rho & 15; return 8 * (i >> 2) + 4 * n + (i & 3); }
struct Unit { int pm, pn; };
struct Gemm { const bf16_t* A; const bf16_t* Bt; int M, N, K, lda; };
struct StaticOrder {
    int nM, nN, nwg, G, c;
    __host__ __device__ void init(int M, int N, int G_, int c_) { nM = M / BM; nN = N / BM; nwg = nM * nN; G = G_; c = c_; }
    __host__ __device__ bool next(int i, Unit& u) const {
        const long L = (long)i * G + c; if (L >= nwg) return false;
        int wgid = (int)L; { const int q = nwg / NXCD, r = nwg % NXCD, xcd = wgid % NXCD, off = wgid / NXCD; wgid = (xcd < r ? xcd * (q + 1) : r * (q + 1) + (xcd - r) * q) + off; }
        const int nig = WGM * nN, gid = wgid / nig, fm = gid * WGM, gsz = (nM - fm) < WGM ? (nM - fm) : WGM;
        u.pm = fm + ((wgid % nig) % gsz); u.pn = (wgid % nig) / gsz; return true;
    }
};
struct EpiBf16 {
    static constexpr bool PERM = true;
    bf16_t* O; int ldc;
    __device__ __forceinline__ void operator()(const f32x4 (&acc)[2][2][4][2], const Unit& u, int wr, int wc, int fr_, int fq_) const {
        const int lane_ = opaque_tid() & 63, fr = lane_ & 15, fq = lane_ >> 4;
        const int row0 = u.pm * BM + wr * 64 + fr; const int col0 = u.pn * BM + wc * 32 + 8 * fq;
#pragma unroll
        for (int ai = 0; ai < 2; ++ai)
#pragma unroll
            for (int m = 0; m < 4; ++m) { bf16_t* rowp = O + (size_t)(row0 + ai * HALF + m * 16) * ldc + col0;
#pragma unroll
                for (int bj = 0; bj < 2; ++bj) { const f32x4 v0 = acc[ai][bj][m][0], v1 = acc[ai][bj][m][1];
                    u32x4 w; w.x = cvt_pk_bf16(v0[0], v0[1]); w.y = cvt_pk_bf16(v0[2], v0[3]); w.z = cvt_pk_bf16(v1[0], v1[1]); w.w = cvt_pk_bf16(v1[2], v1[3]);
                    *(u32x4*)(rowp + bj * HALF) = w; } }
    }
};
struct EpiGateRes {
    static constexpr bool PERM = false;
    const float* xp; const float* xs; float* out; const float* modbuf; int layer; int src_out;
    __device__ __forceinline__ void operator()(const f32x4 (&acc)[2][2][4][2], const Unit& u, int wr, int wc, int fr_, int fq_) const {
        const int lane_ = opaque_tid() & 63, fr = lane_ & 15, fq = lane_ >> 4;
        const int row0 = u.pm * BM + wr * 64 + fr, col0 = u.pn * BM + wc * 32 + 4 * fq;
        const int bi = batch_of_row(u.pm * BM);
        const float* g = modbuf + (size_t)(bi * 2 + layer) * 3072 + 2048;
#ifndef DIAG_LAM_S
#define DIAG_LAM_S 1.0f
#endif
#ifndef DIAG_LAM_P
#define DIAG_LAM_P 1.0f
#endif
        const float lam = (layer == 1) ? (bi >= 16 ? DIAG_LAM_S : DIAG_LAM_P) : 1.0f;
        f32x4 gv[2][2];
#pragma unroll
        for (int bj = 0; bj < 2; ++bj)
#pragma unroll
            for (int n = 0; n < 2; ++n) gv[bj][n] = *(const f32x4*)(g + col0 + bj * HALF + n * 16);
#pragma unroll
        for (int ai = 0; ai < 2; ++ai)
#pragma unroll
            for (int m = 0; m < 4; ++m) { const int row = row0 + ai * HALF + m * 16;
                const float* src = src_out ? out + (size_t)row * DM : (row < M_A ? xp + (size_t)row * DM : xs + (size_t)(row - M_A) * DM);
                float* dst = out + (size_t)row * DM;
#pragma unroll
                for (int bj = 0; bj < 2; ++bj)
#pragma unroll
                    for (int n = 0; n < 2; ++n) { const int c = col0 + bj * HALF + n * 16; const f32x4 xv = *(const f32x4*)(src + c);
                        *(f32x4*)(dst + c) = xv + gv[bj][n] * acc[ai][bj][m][n] * lam; } }
    }
};
struct EpiU1 {
    static constexpr bool PERM = false;
    bf16_t* U1; float* ssq_q; float* ssq_kv; bf16_t* kpe; const float2* rope;
    __device__ __forceinline__ void operator()(const f32x4 (&acc)[2][2][4][2], const Unit& u, int wr, int wc, int fr_, int fq_) const {
        const int lane_ = opaque_tid() & 63, fr = lane_ & 15, fq = lane_ >> 4;
        const int row0 = u.pm * BM + wr * 64 + fr, col0 = u.pn * BM + wc * 32 + 4 * fq;
#pragma unroll
        for (int ai = 0; ai < 2; ++ai)
#pragma unroll
            for (int m = 0; m < 4; ++m) { const int row = row0 + ai * HALF + m * 16; float sq[2] = {0.f, 0.f};
#pragma unroll
                for (int bj = 0; bj < 2; ++bj)
#pragma unroll
                    for (int n = 0; n < 2; ++n) { const f32x4 v = acc[ai][bj][m][n]; u32x2 w; w.x = cvt_pk_bf16(v[0], v[1]); w.y = cvt_pk_bf16(v[2], v[3]);
                        *(u32x2*)(U1 + (size_t)row * OD_INP + col0 + bj * HALF + n * 16) = w; sq[bj] += (v[0] * v[0] + v[1] * v[1]) + (v[2] * v[2] + v[3] * v[3]); }
                if (u.pn == 0) { float s = sq[0] + sq[1]; s += __shfl_xor(s, 16); s += __shfl_xor(s, 32); if (fq == 0) atomicAdd(ssq_q + row, s); }
                else if (u.pn == 1) { float s = sq[0]; s += __shfl_xor(s, 16); s += __shfl_xor(s, 32); if (fq == 0) atomicAdd(ssq_kv + row, s);
                    if (wc == 0) { const int pos = pos_of_row(row); const f32x4 a = acc[ai][1][m][0], b = acc[ai][1][m][1]; float o1[4], o2[4];
#pragma unroll
                        for (int e = 0; e < 4; ++e) { const float2 cs = rope[pos * 16 + 4 * fq + e]; o1[e] = a[e] * cs.x - b[e] * cs.y; o2[e] = b[e] * cs.x + a[e] * cs.y; }
                        u32x2 w1, w2; w1.x = cvt_pk_bf16(o1[0], o1[1]); w1.y = cvt_pk_bf16(o1[2], o1[3]); w2.x = cvt_pk_bf16(o2[0], o2[1]); w2.y = cvt_pk_bf16(o2[2], o2[3]);
                        *(u32x2*)(kpe + (size_t)row * 32 + 4 * fq) = w1; *(u32x2*)(kpe + (size_t)row * 32 + 16 + 4 * fq) = w2; } }
            }
    }
};
struct EpiQ {
    static constexpr bool PERM = false;
    bf16_t* Q; const float* ssq_q; const float2* rope; int row_off;
    __device__ __forceinline__ void operator()(const f32x4 (&acc)[2][2][4][2], const Unit& u, int wr, int wc, int fr_, int fq_) const {
        const int lane_ = opaque_tid() & 63, fr = lane_ & 15, fq = lane_ >> 4;
        const int row0 = u.pm * BM + wr * 64 + fr;
        const int cb0 = u.pn * BM + wc * 32, cb1 = cb0 + HALF; const bool rope0 = ((cb0 >> 5) % 3) == 2, rope1 = ((cb1 >> 5) % 3) == 2;
        float ssv[2][4];
#pragma unroll
        for (int ai = 0; ai < 2; ++ai)
#pragma unroll
            for (int m = 0; m < 4; ++m) ssv[ai][m] = ssq_q[row_off + row0 + ai * HALF + m * 16];
#pragma unroll
        for (int ai = 0; ai < 2; ++ai)
#pragma unroll
            for (int m = 0; m < 4; ++m) { const int rowg = row0 + ai * HALF + m * 16;
                asm volatile("" ::: "memory");
                float2 cs[4];
                if (rope0 || rope1) { const int pos = pos_of_row(row_off + rowg);
#pragma unroll
                    for (int e = 0; e < 4; ++e) cs[e] = rope[pos * 16 + 4 * fq + e]; }
                const float rq = rsqrtf(ssv[ai][m] * (1.0f / 256.0f) + EPS) * QS96;
#pragma unroll
                for (int bj = 0; bj < 2; ++bj) { const int cb = bj ? cb1 : cb0; const bool isrope = bj ? rope1 : rope0;
                    f32x4 v0 = acc[ai][bj][m][0] * rq, v1 = acc[ai][bj][m][1] * rq;
                    if (isrope) {
#pragma unroll
                        for (int e = 0; e < 4; ++e) { const float2 c2 = cs[e]; const float a_ = v0[e], b_ = v1[e]; v0[e] = a_ * c2.x - b_ * c2.y; v1[e] = b_ * c2.x + a_ * c2.y; } }
                    u32x2 w0, w1; w0.x = cvt_pk_bf16(v0[0], v0[1]); w0.y = cvt_pk_bf16(v0[2], v0[3]); w1.x = cvt_pk_bf16(v1[0], v1[1]); w1.y = cvt_pk_bf16(v1[2], v1[3]);
                    *(u32x2*)(Q + (size_t)rowg * 1536 + cb + 4 * fq) = w0; *(u32x2*)(Q + (size_t)rowg * 1536 + cb + 16 + 4 * fq) = w1; } }
    }
};
struct EpiKV {
    static constexpr bool PERM = false;
    bf16_t* Kg; bf16_t* Vg; const float* ssq_kv; int row_off;
    __device__ __forceinline__ void operator()(const f32x4 (&acc)[2][2][4][2], const Unit& u, int wr, int wc, int fr_, int fq_) const {
        const int lane_ = opaque_tid() & 63, fr = lane_ & 15, fq = lane_ >> 4;
        const int row0 = u.pm * BM + wr * 64 + fr; bf16_t* dst = (wc < 2) ? Kg : Vg;
        float ssv[2][4];
#pragma unroll
        for (int ai = 0; ai < 2; ++ai)
#pragma unroll
            for (int m = 0; m < 4; ++m) ssv[ai][m] = ssq_kv[row_off + row0 + ai * HALF + m * 16];
#pragma unroll
        for (int ai = 0; ai < 2; ++ai)
#pragma unroll
            for (int m = 0; m < 4; ++m) { const int rowg = row0 + ai * HALF + m * 16, grow = row_off + rowg;
                const float rk = rsqrtf(ssv[ai][m] * (1.0f / 128.0f) + EPS); (void)grow;
#pragma unroll
                for (int bj = 0; bj < 2; ++bj)
#pragma unroll
                    for (int n = 0; n < 2; ++n) { const int head = 2 * u.pn + bj; const int dcol = head * 64 + (wc & 1) * 32 + 16 * n + 4 * fq; const f32x4 v = acc[ai][bj][m][n] * rk;
                        u32x2 w; w.x = cvt_pk_bf16(v[0], v[1]); w.y = cvt_pk_bf16(v[2], v[3]); *(u32x2*)(dst + (size_t)rowg * 1024 + dcol) = w; } }
    }
};

template <class Epi, class Sched, bool ALIGN_EPI, bool SP2>
__device__ __forceinline__ void gemm_phase(LAS unsigned char* lds, const Gemm g, const Sched& S, const Epi& E) {
    const int tid = opaque_tid(), wid = __builtin_amdgcn_readfirstlane(tid >> 6), lane = tid & 63, wr = wid >> 2, wc = wid & 3, fr = lane & 15, fq = lane >> 4;
    const int K = g.K, nt = K / BK, lda = g.lda;
    unsigned voffA[2], voffB[2];
#pragma unroll
    for (int i = 0; i < 2; ++i) { int R, C; stage_rc(tid * 16 + i * 8192, R, C); const int Rb = Epi::PERM ? ((R & ~31) + perm32(R & 31)) : R;
        voffA[i] = (unsigned)(R * lda + C) * 2u; voffB[i] = (unsigned)(Rb * K + C) * 2u; }
    const size_t kstep = (size_t)(BK * 2);
    const size_t hstepA = (size_t)HALF * lda * 2, hstepB = (size_t)HALF * K * 2;
    const size_t tstepA = 2 * hstepA, tstepB = 2 * hstepB;
    const unsigned ldsw = (unsigned)wid * 1024u;
    const int aoff = lds_byte(wr * 64 + fr, fq * 8), boff = lds_byte(wc * 32 + fr, fq * 8);
#define PG8_SA(b, h) (((b) * 2 + (h)) * HTB)
#define PG8_SB(b, h) ((4 + (b) * 2 + (h)) * HTB)
#define PG8_STAGE(bufoff, gbase, voff) do { _Pragma("unroll") for (int _i = 0; _i < 2; ++_i) \
        __builtin_amdgcn_global_load_lds((const unsigned*)((const char*)(gbase) + (voff)[_i]), (LAS unsigned*)(lds + (bufoff) + ldsw + _i * 8192), 16, 0, 0); } while (0)
#define PG8_LDA(dst, b, h) do { _Pragma("unroll") for (int m = 0; m < 4; ++m) _Pragma("unroll") for (int k = 0; k < 2; ++k) dst[m][k] = *(const LAS bf16x8*)(lds + PG8_SA(b, h) + aoff + m * 2048 + k * 1024); } while (0)
#define PG8_LDB(dst, b, h) do { _Pragma("unroll") for (int n = 0; n < 2; ++n) _Pragma("unroll") for (int k = 0; k < 2; ++k) dst[n][k] = *(const LAS bf16x8*)(lds + PG8_SB(b, h) + boff + n * 2048 + k * 1024); } while (0)
#define PG8_MMA(ai, bj, At, Bt) do { __builtin_amdgcn_s_setprio(1); _Pragma("unroll") for (int m = 0; m < 4; ++m) _Pragma("unroll") for (int n = 0; n < 2; ++n) _Pragma("unroll") for (int k = 0; k < 2; ++k) \
        acc[ai][bj][m][n] = __builtin_amdgcn_mfma_f32_16x16x32_bf16(Bt[n][k], At[m][k], acc[ai][bj][m][n], 0, 0, 0); __builtin_amdgcn_s_setprio(0); } while (0)
#define PG8_WAIT_V(n) asm volatile("s_waitcnt vmcnt(" #n ")" ::: "memory")
#define PG8_WAIT_L(n) asm volatile("s_waitcnt lgkmcnt(" #n ")" ::: "memory")
#define PG8_BAR __builtin_amdgcn_s_barrier()
#define PG8_SCHED __builtin_amdgcn_sched_barrier(0)
    Unit cur, nxt; int ui = 0;
    if (!S.next(0, cur)) return;
    f32x4 acc[2][2][4][2];
#pragma unroll
    for (int a = 0; a < 2; ++a)
#pragma unroll
        for (int b = 0; b < 2; ++b)
#pragma unroll
            for (int m = 0; m < 4; ++m)
#pragma unroll
                for (int n = 0; n < 2; ++n) acc[a][b][m][n] = (f32x4){0.f, 0.f, 0.f, 0.f};
    bf16x8 At[4][2], B0[2][2], B1[2][2];
    const char* cA = (const char*)g.A + (size_t)cur.pm * tstepA; const char* cB = (const char*)g.Bt + (size_t)cur.pn * tstepB;
    if constexpr (SP2) {
        PG8_STAGE(PG8_SB(0, 0), cB, voffB); PG8_STAGE(PG8_SB(0, 1), cB + hstepB, voffB); PG8_STAGE(PG8_SA(0, 0), cA, voffA); PG8_STAGE(PG8_SA(0, 1), cA + hstepA, voffA);
        if (wr == 1) PG8_BAR;
        PG8_WAIT_V(2); PG8_BAR;
        PG8_STAGE(PG8_SB(1, 0), cB + kstep, voffB); PG8_STAGE(PG8_SA(1, 0), cA + kstep, voffA); PG8_STAGE(PG8_SB(1, 1), cB + hstepB + kstep, voffB);
        PG8_WAIT_V(6); PG8_BAR;
    }
    for (;;) {
        const bool has_next = S.next(ui + 1, nxt);
        const char* nA = has_next ? (const char*)g.A + (size_t)nxt.pm * tstepA : cA; const char* nB = has_next ? (const char*)g.Bt + (size_t)nxt.pn * tstepB : cB;
        for (int t = 0; t < nt; t += 2) {
            const bool last = (t == nt - 2);
            const char* a1 = cA + (size_t)(t + 1) * kstep;
            const char* a2 = last ? nA : cA + (size_t)(t + 2) * kstep; const char* b2 = last ? nB : cB + (size_t)(t + 2) * kstep;
            const char* a3 = a2 + kstep; const char* b3 = b2 + kstep;
            PG8_LDB(B0, 0, 0); PG8_LDB(B1, 0, 1); PG8_SCHED; PG8_LDA(At, 0, 0); PG8_STAGE(PG8_SA(1, 1), a1 + hstepA, voffA);
            PG8_WAIT_V(8); PG8_WAIT_L(0); PG8_BAR; PG8_MMA(0, 0, At, B0); PG8_MMA(0, 1, At, B1); PG8_BAR; PG8_SCHED;
            PG8_LDA(At, 0, 1); PG8_STAGE(PG8_SB(0, 0), b2, voffB); PG8_STAGE(PG8_SB(0, 1), b2 + hstepB, voffB); PG8_STAGE(PG8_SA(0, 0), a2, voffA);
            PG8_WAIT_V(8); PG8_WAIT_L(0); PG8_BAR; PG8_MMA(1, 0, At, B0); PG8_MMA(1, 1, At, B1); PG8_BAR; PG8_SCHED;
            PG8_LDB(B0, 1, 0); PG8_LDB(B1, 1, 1); PG8_SCHED; PG8_LDA(At, 1, 0); PG8_STAGE(PG8_SA(0, 1), a2 + hstepA, voffA);
            PG8_WAIT_V(8); PG8_WAIT_L(0); PG8_BAR; PG8_MMA(0, 0, At, B0); PG8_MMA(0, 1, At, B1); PG8_BAR; PG8_SCHED;
            PG8_LDA(At, 1, 1); PG8_STAGE(PG8_SB(1, 0), b3, voffB); PG8_STAGE(PG8_SB(1, 1), b3 + hstepB, voffB); PG8_STAGE(PG8_SA(1, 0), a3, voffA);
            PG8_WAIT_V(8); PG8_WAIT_L(0); PG8_BAR; PG8_MMA(1, 0, At, B0); PG8_MMA(1, 1, At, B1); PG8_BAR; PG8_SCHED;
        }
        if constexpr (ALIGN_EPI) { if (wr == 0) PG8_BAR; }
        E(acc, cur, wr, wc, fr, fq);
        if (!has_next) break;
#pragma unroll
        for (int a = 0; a < 2; ++a)
#pragma unroll
            for (int b = 0; b < 2; ++b)
#pragma unroll
                for (int m = 0; m < 4; ++m)
#pragma unroll
                    for (int n = 0; n < 2; ++n) acc[a][b][m][n] = (f32x4){0.f, 0.f, 0.f, 0.f};
        cur = nxt; cA = nA; cB = nB; ++ui;
        if constexpr (ALIGN_EPI) { if (wr == 1) PG8_BAR; }
    }
    PG8_WAIT_V(0);
    if constexpr (!ALIGN_EPI) { if (wr == 0) PG8_BAR; }
    PG8_BAR;
#undef PG8_SA
#undef PG8_SB
#undef PG8_STAGE
#undef PG8_LDA
#undef PG8_LDB
#undef PG8_MMA
#undef PG8_WAIT_V
#undef PG8_WAIT_L
#undef PG8_BAR
#undef PG8_SCHED
}
}

constexpr float THR2 = 11.0f;
constexpr int KSTR = 208;
constexpr int A_KBUF = 64 * KSTR, A_VBUF = 8192;
constexpr int A_K0 = 0, A_V0 = 2 * A_KBUF, A_WS = A_V0 + 2 * A_VBUF, A_TAB = A_WS + 2048;
__device__ __forceinline__ int crow(int r, int hi) { return (r & 3) + 8 * (r >> 2) + 4 * hi; }
__device__ __forceinline__ int v_st(int k, int c) { const int kk = (k & ~0xC) | ((k & 4) << 1) | ((k & 8) >> 1); return ((kk >> 3) * 2 + (c >> 5)) * 512 + ((kk & 7) * 32 + (c & 31)) * 2; }
__device__ __forceinline__ int v_rd_base(int lane) { return ((lane & 3) << 3) | (((lane >> 2) & 3) << 6) | (((lane >> 4) & 1) << 5) | (((lane >> 5) & 1) << 8); }
constexpr int v_rd_off(int d0, int ks, int half) { return d0 * 512 + ks * 2048 + half * 1024; }
template <int OFF> __device__ __forceinline__ s16x4 tr_read(int vb) {
    s16x4 r; asm volatile("ds_read_b64_tr_b16 %0, %1 offset:%2" : "=&v"(r) : "v"(vb), "i"(OFF) : "memory"); return r;
}
template <int D0> __device__ __forceinline__ void pv_one(f32x16& od, int vb, bf16x8 pa0, bf16x8 pa1, bf16x8 pa2, bf16x8 pa3) {
    const s16x4 l0 = tr_read<v_rd_off(D0, 0, 0)>(vb), h0 = tr_read<v_rd_off(D0, 0, 1)>(vb), l1 = tr_read<v_rd_off(D0, 1, 0)>(vb), h1 = tr_read<v_rd_off(D0, 1, 1)>(vb);
    const s16x4 l2 = tr_read<v_rd_off(D0, 2, 0)>(vb), h2 = tr_read<v_rd_off(D0, 2, 1)>(vb), l3 = tr_read<v_rd_off(D0, 3, 0)>(vb), h3 = tr_read<v_rd_off(D0, 3, 1)>(vb);
    asm volatile("s_waitcnt lgkmcnt(0)" ::: "memory"); __builtin_amdgcn_sched_barrier(0);
#define PK(L, H) (bf16x8){L[0], L[1], L[2], L[3], H[0], H[1], H[2], H[3]}
    od = __builtin_amdgcn_mfma_f32_32x32x16_bf16(pa0, PK(l0, h0), od, 0, 0, 0);
    od = __builtin_amdgcn_mfma_f32_32x32x16_bf16(pa1, PK(l1, h1), od, 0, 0, 0);
    od = __builtin_amdgcn_mfma_f32_32x32x16_bf16(pa2, PK(l2, h2), od, 0, 0, 0);
    od = __builtin_amdgcn_mfma_f32_32x32x16_bf16(pa3, PK(l3, h3), od, 0, 0, 0);
#undef PK
}

__device__ __forceinline__ void pv_both(f32x16& o0, f32x16& o1, int vb, bf16x8 pa0, bf16x8 pa1, bf16x8 pa2, bf16x8 pa3) {
    const s16x4 l0 = tr_read<v_rd_off(0, 0, 0)>(vb), h0 = tr_read<v_rd_off(0, 0, 1)>(vb), l1 = tr_read<v_rd_off(0, 1, 0)>(vb), h1 = tr_read<v_rd_off(0, 1, 1)>(vb);
    const s16x4 l2 = tr_read<v_rd_off(0, 2, 0)>(vb), h2 = tr_read<v_rd_off(0, 2, 1)>(vb), l3 = tr_read<v_rd_off(0, 3, 0)>(vb), h3 = tr_read<v_rd_off(0, 3, 1)>(vb);
    const s16x4 m0 = tr_read<v_rd_off(1, 0, 0)>(vb), n0 = tr_read<v_rd_off(1, 0, 1)>(vb), m1 = tr_read<v_rd_off(1, 1, 0)>(vb), n1 = tr_read<v_rd_off(1, 1, 1)>(vb);
    const s16x4 m2 = tr_read<v_rd_off(1, 2, 0)>(vb), n2 = tr_read<v_rd_off(1, 2, 1)>(vb), m3 = tr_read<v_rd_off(1, 3, 0)>(vb), n3 = tr_read<v_rd_off(1, 3, 1)>(vb);
    asm volatile("s_waitcnt lgkmcnt(8)" ::: "memory"); __builtin_amdgcn_sched_barrier(0);
#define PK(L, H) (bf16x8){L[0], L[1], L[2], L[3], H[0], H[1], H[2], H[3]}
    o0 = __builtin_amdgcn_mfma_f32_32x32x16_bf16(pa0, PK(l0, h0), o0, 0, 0, 0);
    o0 = __builtin_amdgcn_mfma_f32_32x32x16_bf16(pa1, PK(l1, h1), o0, 0, 0, 0);
    o0 = __builtin_amdgcn_mfma_f32_32x32x16_bf16(pa2, PK(l2, h2), o0, 0, 0, 0);
    o0 = __builtin_amdgcn_mfma_f32_32x32x16_bf16(pa3, PK(l3, h3), o0, 0, 0, 0);
    asm volatile("s_waitcnt lgkmcnt(0)" ::: "memory"); __builtin_amdgcn_sched_barrier(0);
    o1 = __builtin_amdgcn_mfma_f32_32x32x16_bf16(pa0, PK(m0, n0), o1, 0, 0, 0);
    o1 = __builtin_amdgcn_mfma_f32_32x32x16_bf16(pa1, PK(m1, n1), o1, 0, 0, 0);
    o1 = __builtin_amdgcn_mfma_f32_32x32x16_bf16(pa2, PK(m2, n2), o1, 0, 0, 0);
    o1 = __builtin_amdgcn_mfma_f32_32x32x16_bf16(pa3, PK(m3, n3), o1, 0, 0, 0);
#undef PK
}
__device__ __forceinline__ void mla_qkt_neg(f32x16& p0, f32x16& p1, const f32x16& negm, const unsigned char* Kb, const bf16x8* qr, int r32, int hi) {
#pragma unroll
    for (int d0 = 0; d0 < 6; ++d0) { const int cb = (d0 * 16 + hi * 8) * 2;
        const bf16x8 b0 = *(const bf16x8*)(Kb + r32 * KSTR + cb), b1 = *(const bf16x8*)(Kb + (32 + r32) * KSTR + cb);
        if (d0 == 0) { p0 = __builtin_amdgcn_mfma_f32_32x32x16_bf16(b0, qr[0], negm, 0, 0, 0); p1 = __builtin_amdgcn_mfma_f32_32x32x16_bf16(b1, qr[0], negm, 0, 0, 0); }
        else { p0 = __builtin_amdgcn_mfma_f32_32x32x16_bf16(b0, qr[d0], p0, 0, 0, 0); p1 = __builtin_amdgcn_mfma_f32_32x32x16_bf16(b1, qr[d0], p1, 0, 0, 0); } }
}
__device__ __forceinline__ void mla_softmax_rel(f32x16& p0, f32x16& p1, f32x16& negm, bool first, float& l_reg, float& alpha, bf16x8& pa0, bf16x8& pa1, bf16x8& pa2, bf16x8& pa3) {
    float pmax = p0[0];
#pragma unroll
    for (int r = 1; r < 16; ++r) pmax = fmaxf(pmax, p0[r]);
#pragma unroll
    for (int r = 0; r < 16; ++r) pmax = fmaxf(pmax, p1[r]);
    { auto rr = __builtin_amdgcn_permlane32_swap(__float_as_uint(pmax), __float_as_uint(pmax), false, false); pmax = fmaxf(__uint_as_float(rr[0]), __uint_as_float(rr[1])); }
    alpha = 1.f;
    if (__builtin_expect(first || !__all(pmax <= THR2), 0)) {
        const float d = first ? pmax : fmaxf(pmax, 0.f);
        if (!first) alpha = __builtin_amdgcn_exp2f(-d);
        const float nm = negm[0] - d;
#pragma unroll
        for (int r = 0; r < 16; ++r) { negm[r] = nm; p0[r] -= d; p1[r] -= d; }
    }
#pragma unroll
    for (int r = 0; r < 16; ++r) { p0[r] = __builtin_amdgcn_exp2f(p0[r]); p1[r] = __builtin_amdgcn_exp2f(p1[r]); }
    float ps = 0.f;
#pragma unroll
    for (int r = 0; r < 16; ++r) ps += p0[r];
#pragma unroll
    for (int r = 0; r < 16; ++r) ps += p1[r];
    { auto rr = __builtin_amdgcn_permlane32_swap(__float_as_uint(ps), __float_as_uint(ps), false, false); ps = __uint_as_float(rr[0]) + __uint_as_float(rr[1]); }
    l_reg = l_reg * alpha + ps;
#define PK4(Pv, BASE, OUT) do { unsigned a0 = cvt_pk_bf16(Pv[BASE + 0], Pv[BASE + 1]), a1 = cvt_pk_bf16(Pv[BASE + 2], Pv[BASE + 3]);   \
    unsigned b0_ = cvt_pk_bf16(Pv[BASE + 4], Pv[BASE + 5]), b1_ = cvt_pk_bf16(Pv[BASE + 6], Pv[BASE + 7]);                              \
    auto r0 = __builtin_amdgcn_permlane32_swap(a0, b0_, false, false); auto r1 = __builtin_amdgcn_permlane32_swap(a1, b1_, false, false); \
    u32x4 w = {r0[0], r1[0], r0[1], r1[1]}; OUT = *reinterpret_cast<bf16x8*>(&w); } while (0)
    PK4(p0, 0, pa0); PK4(p0, 8, pa1); PK4(p1, 0, pa2); PK4(p1, 8, pa3);
#undef PK4
}
__device__ __forceinline__ void mla_softmax_rel_kp(f32x16& p0, f32x16& p1, f32x16& negm, bool first, float& l_reg, float& alpha, bf16x8& pa0, bf16x8& pa1, bf16x8& pa2, bf16x8& pa3) {
    float pmax = p0[0];
#pragma unroll
    for (int r = 1; r < 16; ++r) pmax = fmaxf(pmax, p0[r]);
#pragma unroll
    for (int r = 0; r < 16; ++r) pmax = fmaxf(pmax, p1[r]);
    { auto rr = __builtin_amdgcn_permlane32_swap(__float_as_uint(pmax), __float_as_uint(pmax), false, false); pmax = fmaxf(__uint_as_float(rr[0]), __uint_as_float(rr[1])); }
    alpha = 1.f;
    if (__builtin_expect(first || !__all(pmax <= THR2), 0)) {
        const float d = first ? pmax : fmaxf(pmax, 0.f);
        if (!first) alpha = __builtin_amdgcn_exp2f(-d);
        const float nm = negm[0] - d;
#pragma unroll
        for (int r = 0; r < 16; ++r) { negm[r] = nm; p0[r] -= d; p1[r] -= d; }
    }
#pragma unroll
    for (int r = 0; r < 16; ++r) { p0[r] = __builtin_amdgcn_exp2f(p0[r]); p1[r] = __builtin_amdgcn_exp2f(p1[r]); }
    float ps = 0.f;
#pragma unroll
    for (int r = 0; r < 16; ++r) ps += p0[r];
#pragma unroll
    for (int r = 0; r < 16; ++r) ps += p1[r];
    { auto rr = __builtin_amdgcn_permlane32_swap(__float_as_uint(ps), __float_as_uint(ps), false, false); ps = __uint_as_float(rr[0]) + __uint_as_float(rr[1]); }
    l_reg = l_reg * alpha + ps;
    pa0 = pack8(p0, 0); pa1 = pack8(p0, 8); pa2 = pack8(p1, 0); pa3 = pack8(p1, 8);
}
template <int MODE>
__device__ __forceinline__ void attn_unit(const Params& P, unsigned char* lds, int h, int rb, int grp, bool dry = false) {
    constexpr int ND = (MODE == 2) ? 6 : 4;
    const int tid = opaque_tid(), lane = tid & 63, r32 = lane & 31, hi = lane >> 5; const int wid = __builtin_amdgcn_readfirstlane(tid >> 6);
    unsigned char* ws = P.ws;
    int l, seq0, t0; size_t rowoff = 0;
    const bf16_t *Qp, *Kp, *Vp, *Kpe = nullptr; bf16_t* Gp; int ldq, ldk, ldg;
    if (MODE == 2) {
        l = grp ? 16384 : 2048; rowoff = grp ? M_A : 0; const int m0 = rb * 256; seq0 = m0 & ~(l - 1); t0 = m0 - seq0;
        Qp = (const bf16_t*)(ws + WS_QG) + h * 96; ldq = 1536; Kp = (const bf16_t*)(ws + WS_KG) + h * 64; Vp = (const bf16_t*)(ws + WS_VG) + h * 64; ldk = 1024;
        Kpe = (const bf16_t*)(ws + WS_KPE) + rowoff * 32; Gp = (bf16_t*)(ws + WS_U1) + rowoff * OD_INP + 416 + h * 64; ldg = OD_INP;
    } else {
        const int m0 = rb * 256;
        if (m0 < M_A) { l = 2048; seq0 = m0 & ~2047; } else { l = 16384; seq0 = M_A + ((m0 - M_A) & ~16383); }
        t0 = m0 - seq0; const bf16_t* U0 = (const bf16_t*)(ws + WS_U0); ldq = ldk = ldg = EV_IN;
        if (MODE == 0) { Qp = U0 + h * 64; Kp = U0 + 512 + h * 64; Vp = U0 + 1024 + h * 64; Gp = (bf16_t*)(ws + WS_U0) + 2304 + h * 64; }
        else { Qp = U0 + 1536 + h * 64; Kp = U0 + 2048 + (h >> 2) * 64; Vp = U0 + 2176 + (h >> 2) * 64; Gp = (bf16_t*)(ws + WS_U0) + 2304 + 512 + h * 64; }
    }
    int NT, key0;
    int na_r = 0, na_rs = 0, na_tlo = 0, na_cq = 0, na_cs = 0;
    if (MODE == 0) { const int rows = l >> 6, R4 = t0 >> 6;
        auto rsf = [&](int r) { int s = r - 4; s = s < 0 ? 0 : s; return s > rows - 8 ? rows - 8 : s; };
        na_tlo = rsf(R4); NT = rsf(R4 + 3) + 8 - na_tlo; key0 = na_tlo * 64;
        na_r = R4 + (wid >> 1); na_rs = rsf(na_r); na_cq = (wid & 1) * 32 + r32; na_cs = na_cq - 8; na_cs = na_cs < 0 ? 0 : (na_cs > 48 ? 48 : na_cs);
    } else if (MODE == 1) { const int jlo = (t0 == 0) ? 2 : 0; int jhi = (l - t0 + 128) >> 6; jhi = jhi > 8 ? 8 : jhi; NT = jhi - jlo; key0 = t0 - 128 + 64 * jlo;
    } else { NT = l >> 6; key0 = 0; }
    float* tab = (float*)(lds + A_TAB);
    if (MODE == 0) {
        const float* rpb = P.na_rpb + (size_t)h * 15 * 31;
        for (int i = tid; i < 15 * 128; i += 512) { const int dr = i >> 7, dc = (i & 127) - 63; tab[i] = (dc >= -15 && dc <= 15) ? rpb[dr * 31 + dc + 15] * LOG2E : 0.f; }
    } else if (MODE == 1) {
        for (int i = tid; i < 1024; i += 512) { const int rel = i - 512; tab[i] = (rel >= -128 && rel <= 128) ? P.t5_bias[(int)T5_BUCKET[rel + 128] * 8 + h] * LOG2E : 0.f; }
    }
    bf16x8 qr[ND];
    { const bf16_t* Qw = Qp + (size_t)(seq0 + t0 + wid * 32 + r32) * ldq + hi * 8;
#pragma unroll
      for (int d0 = 0; d0 < ND; ++d0) qr[d0] = *(const bf16x8*)(Qw + d0 * 16); }
    float* wsf = (float*)(lds + A_WS) + wid * 64; float* li_l = wsf; float* al_l = wsf + 32;
    float m_reg = -1e30f, l_reg = 0.f; f32x16 o[2] = {};
    if (dry) Gp = (bf16_t*)(ws + WS_END) + h * 64 - (size_t)(seq0 + t0) * ldg + (size_t)((rb & 7) * 256) * ldg;
    bf16_t* Gw = Gp + (size_t)(seq0 + t0 + wid * 32) * ldg + r32;
    bf16_t gq[32];
#pragma unroll
    for (int r = 0; r < 16; ++r) { const int orow = crow(r, hi); gq[2 * r] = Gw[(size_t)orow * ldg]; gq[2 * r + 1] = Gw[(size_t)orow * ldg + 32]; }
    const int sr = tid >> 3, sc = (tid & 7) * 8, pr = tid >> 2, pc = (tid & 3) * 8;
    const int vst = v_st(sr, sc);
    const int vb0 = (int)(uintptr_t)(lds + A_V0) + v_rd_base(lane);
    bf16x8 kst, vstg, pst;
#define SLOAD(j) do { const size_t krow = (size_t)(seq0 + key0 + 64 * (j) + sr); kst = *(const bf16x8*)(Kp + krow * ldk + sc); vstg = *(const bf16x8*)(Vp + krow * ldk + sc); \
        if (MODE == 2) { if (tid < 256) pst = *(const bf16x8*)(Kpe + (size_t)(seq0 + key0 + 64 * (j) + pr) * 32 + pc); } } while (0)
#define SWRITE(b) do { *(bf16x8*)(lds + A_K0 + (b) * A_KBUF + sr * KSTR + sc * 2) = kst; *(bf16x8*)(lds + A_V0 + (b) * A_VBUF + vst) = vstg; \
        if (MODE == 2) { if (tid < 256) *(bf16x8*)(lds + A_K0 + (b) * A_KBUF + pr * KSTR + 128 + pc * 2) = pst; } } while (0)
    SLOAD(0); SWRITE(0); __syncthreads();
    for (int j = 0; j < NT; ++j) {
        const int buf = j & 1;
        if (j + 1 < NT) SLOAD(j + 1);
        bool active = true;
        if (MODE == 0) { const int kr = na_tlo + j; active = (kr >= na_rs) && (kr < na_rs + 8); }
        if (MODE == 1) { const int jj = (key0 - t0 + 128) / 64 + j; active = (64 * jj + 63 >= 32 * wid) && (64 * jj <= 32 * wid + 287); }
        if (active) {
            f32x16 p0 = {}, p1 = {};
            const unsigned char* Kb = lds + A_K0 + buf * A_KBUF;
#pragma unroll
            for (int d0 = 0; d0 < ND; ++d0) { const int cb = (d0 * 16 + hi * 8) * 2;
                const bf16x8 b0 = *(const bf16x8*)(Kb + r32 * KSTR + cb), b1 = *(const bf16x8*)(Kb + (32 + r32) * KSTR + cb);
                p0 = __builtin_amdgcn_mfma_f32_32x32x16_bf16(b0, qr[d0], p0, 0, 0, 0);
                p1 = __builtin_amdgcn_mfma_f32_32x32x16_bf16(b1, qr[d0], p1, 0, 0, 0); }
            if (MODE == 0) { const int dr = na_tlo + j - na_r; const float* tb = tab + (dr + 7) * 128 + (4 * hi - na_cq + 63); const int v = 4 * hi - na_cs;
#pragma unroll
                for (int r = 0; r < 16; ++r) { const int c0 = (r & 3) + 8 * (r >> 2);
                    p0[r] = ((unsigned)(c0 + v) < 16u) ? p0[r] + tb[c0] : -1e30f;
                    p1[r] = ((unsigned)(c0 + 32 + v) < 16u) ? p1[r] + tb[c0 + 32] : -1e30f; } }
            if (MODE == 1) { const int base = key0 + 64 * j - t0 + 4 * hi - 32 * wid - r32; const float* tb = tab + 512 + base;
#pragma unroll
                for (int r = 0; r < 16; ++r) { const int c0 = (r & 3) + 8 * (r >> 2);
                    p0[r] = ((unsigned)(base + c0 + 128) <= 256u) ? p0[r] + tb[c0] : -1e30f;
                    p1[r] = ((unsigned)(base + c0 + 32 + 128) <= 256u) ? p1[r] + tb[c0 + 32] : -1e30f; } }
            float pmax = p0[0];
#pragma unroll
            for (int r = 1; r < 16; ++r) pmax = fmaxf(pmax, p0[r]);
#pragma unroll
            for (int r = 0; r < 16; ++r) pmax = fmaxf(pmax, p1[r]);
            { auto rr = __builtin_amdgcn_permlane32_swap(__float_as_uint(pmax), __float_as_uint(pmax), false, false); pmax = fmaxf(__uint_as_float(rr[0]), __uint_as_float(rr[1])); }
            const float mn = fmaxf(m_reg, pmax); const float alpha = __builtin_amdgcn_exp2f(m_reg - mn); m_reg = mn;
#pragma unroll
            for (int r = 0; r < 16; ++r) { p0[r] = __builtin_amdgcn_exp2f(p0[r] - mn); p1[r] = __builtin_amdgcn_exp2f(p1[r] - mn); }
            float ps = 0.f;
#pragma unroll
            for (int r = 0; r < 16; ++r) ps += p0[r] + p1[r];
            { auto rr = __builtin_amdgcn_permlane32_swap(__float_as_uint(ps), __float_as_uint(ps), false, false); ps = __uint_as_float(rr[0]) + __uint_as_float(rr[1]); }
            l_reg = l_reg * alpha + ps;
            if (__any(alpha < 1.f)) { if (hi == 0) al_l[r32] = alpha; LDS_WAIT();
#pragma unroll
                for (int d = 0; d < 2; ++d)
#pragma unroll
                    for (int r = 0; r < 16; ++r) o[d][r] *= al_l[crow(r, hi)];
                LDS_WAIT(); }
            bf16x8 pa0, pa1, pa2, pa3;
#define PK4(Pv, BASE, OUT) do { unsigned a0 = cvt_pk_bf16(Pv[BASE + 0], Pv[BASE + 1]), a1 = cvt_pk_bf16(Pv[BASE + 2], Pv[BASE + 3]);   \
    unsigned b0_ = cvt_pk_bf16(Pv[BASE + 4], Pv[BASE + 5]), b1_ = cvt_pk_bf16(Pv[BASE + 6], Pv[BASE + 7]);                              \
    auto r0 = __builtin_amdgcn_permlane32_swap(a0, b0_, false, false); auto r1 = __builtin_amdgcn_permlane32_swap(a1, b1_, false, false); \
    u32x4 w = {r0[0], r1[0], r0[1], r1[1]}; OUT = *reinterpret_cast<bf16x8*>(&w); } while (0)
            PK4(p0, 0, pa0); PK4(p0, 8, pa1); PK4(p1, 0, pa2); PK4(p1, 8, pa3);
#undef PK4
            const int vb = vb0 + buf * A_VBUF;
            pv_both(o[0], o[1], vb, pa0, pa1, pa2, pa3);
        }
        if (j + 1 < NT) SWRITE((j + 1) & 1);
        __syncthreads();
    }
#undef SLOAD
#undef SWRITE
    if (MODE == 1) l_reg += __builtin_amdgcn_exp2f(P.wb_sink[h] * LOG2E - m_reg);
    if (hi == 0) li_l[r32] = l_reg; LDS_WAIT();
    float rli[16];
#pragma unroll
    for (int r = 0; r < 16; ++r) rli[r] = __builtin_amdgcn_rcpf(li_l[crow(r, hi)]);
#pragma unroll
    for (int r = 0; r < 16; ++r) { const int orow = crow(r, hi);
#pragma unroll
        for (int d0 = 0; d0 < 2; ++d0) { bf16_t* gp = Gw + (size_t)orow * ldg + d0 * 32; const float g = bf2f(gq[2 * r + d0]);
            const float sg = g * __builtin_amdgcn_rcpf(1.f + __builtin_amdgcn_exp2f(-g * LOG2E));
            *gp = (bf16_t)(cvt_pk_bf16(o[d0][r] * rli[r] * sg, 0.f) & 0xffffu); } }
    LDS_WAIT();
}

__device__ __forceinline__ void mla_partialSM(f32x16& p0, f32x16& p1, float& m_reg, float& alpha) {
    float pmax = p0[0];
#pragma unroll
    for (int r = 1; r < 16; ++r) pmax = fmaxf(pmax, p0[r]);
#pragma unroll
    for (int r = 0; r < 16; ++r) pmax = fmaxf(pmax, p1[r]);
    { auto rr = __builtin_amdgcn_permlane32_swap(__float_as_uint(pmax), __float_as_uint(pmax), false, false); pmax = fmaxf(__uint_as_float(rr[0]), __uint_as_float(rr[1])); }
    float mn;
    if (__builtin_expect(__all(pmax - m_reg <= THR2), 1)) { mn = m_reg; alpha = 1.f; }
    else { mn = fmaxf(m_reg, pmax); alpha = __builtin_amdgcn_exp2f(m_reg - mn); m_reg = mn; }
#pragma unroll
    for (int r = 0; r < 16; ++r) { p0[r] -= mn; p1[r] -= mn; }
#pragma unroll
    for (int r = 0; r < 16; ++r) p0[r] = __builtin_amdgcn_exp2f(p0[r]);
}
__device__ __forceinline__ void mla_finishSM(f32x16& p0, f32x16& p1, float alpha, float& l_reg, bf16x8& pa0, bf16x8& pa1, bf16x8& pa2, bf16x8& pa3) {
#pragma unroll
    for (int r = 0; r < 16; ++r) p1[r] = __builtin_amdgcn_exp2f(p1[r]);
    float ps = 0.f;
#pragma unroll
    for (int r = 0; r < 16; ++r) ps += p0[r];
#pragma unroll
    for (int r = 0; r < 16; ++r) ps += p1[r];
    { auto rr = __builtin_amdgcn_permlane32_swap(__float_as_uint(ps), __float_as_uint(ps), false, false); ps = __uint_as_float(rr[0]) + __uint_as_float(rr[1]); }
    l_reg = l_reg * alpha + ps;
#define PK4(Pv, BASE, OUT) do { unsigned a0 = cvt_pk_bf16(Pv[BASE + 0], Pv[BASE + 1]), a1 = cvt_pk_bf16(Pv[BASE + 2], Pv[BASE + 3]);   \
    unsigned b0_ = cvt_pk_bf16(Pv[BASE + 4], Pv[BASE + 5]), b1_ = cvt_pk_bf16(Pv[BASE + 6], Pv[BASE + 7]);                              \
    auto r0 = __builtin_amdgcn_permlane32_swap(a0, b0_, false, false); auto r1 = __builtin_amdgcn_permlane32_swap(a1, b1_, false, false); \
    u32x4 w = {r0[0], r1[0], r0[1], r1[1]}; OUT = *reinterpret_cast<bf16x8*>(&w); } while (0)
    PK4(p0, 0, pa0); PK4(p0, 8, pa1); PK4(p1, 0, pa2); PK4(p1, 8, pa3);
#undef PK4
}
__device__ __forceinline__ void mla_qkt(f32x16& p0, f32x16& p1, const unsigned char* Kb, const bf16x8* qr, int r32, int hi) {
    p0 = f32x16{}; p1 = f32x16{};
#pragma unroll
    for (int d0 = 0; d0 < 6; ++d0) { const int cb = (d0 * 16 + hi * 8) * 2;
        const bf16x8 b0 = *(const bf16x8*)(Kb + r32 * KSTR + cb), b1 = *(const bf16x8*)(Kb + (32 + r32) * KSTR + cb);
        p0 = __builtin_amdgcn_mfma_f32_32x32x16_bf16(b0, qr[d0], p0, 0, 0, 0);
        p1 = __builtin_amdgcn_mfma_f32_32x32x16_bf16(b1, qr[d0], p1, 0, 0, 0); }
}
__device__ __forceinline__ void mla_unit(const Params& P, unsigned char* lds, int h, int rb, int grp, bool dry = false) {
    const int tid = opaque_tid(), lane = tid & 63, r32 = lane & 31, hi = lane >> 5; const int wid = __builtin_amdgcn_readfirstlane(tid >> 6);
    unsigned char* ws = P.ws;
    const int l = grp ? 16384 : 2048; const size_t rowoff = grp ? M_A : 0; const int m0 = rb * 256; const int seq0 = m0 & ~(l - 1), t0 = m0 - seq0;
    const bf16_t* Qp = (const bf16_t*)(ws + WS_QG) + h * 96; const bf16_t* Kp = (const bf16_t*)(ws + WS_KG) + h * 64; const bf16_t* Vp = (const bf16_t*)(ws + WS_VG) + h * 64;
    const bf16_t* Kpe = (const bf16_t*)(ws + WS_KPE) + rowoff * 32; bf16_t* Gp = (bf16_t*)(ws + WS_U1) + rowoff * OD_INP + 416 + h * 64; const int ldg = OD_INP;
    const int NT = l >> 6;
    bf16x8 qr[6];
    { const bf16_t* Qw = Qp + (size_t)(seq0 + t0 + wid * 32 + r32) * 1536 + hi * 8;
#pragma unroll
      for (int d0 = 0; d0 < 6; ++d0) qr[d0] = *(const bf16x8*)(Qw + d0 * 16); }
    float* wsf = (float*)(lds + A_WS) + wid * 64; float* li_l = wsf; float* al_l = wsf + 32;
    float m_reg = -1e30f, l_reg = 0.f; f32x16 o[2] = {};
    const int sr = tid >> 3, sc = (tid & 7) * 8, pr = (tid & 255) >> 2, pc = (tid & 3) * 8;
    const int vst = v_st(sr, sc);
    const int vb0 = (int)(uintptr_t)(lds + A_V0) + v_rd_base(lane);
    bf16x8 ksE, vsE, psE, ksO, vsO, psO;
#define SLOAD(S, j) do { const size_t krow = (size_t)(seq0 + 64 * (j) + sr); ks##S = *(const bf16x8*)(Kp + krow * 1024 + sc); vs##S = *(const bf16x8*)(Vp + krow * 1024 + sc); \
        ps##S = *(const bf16x8*)(Kpe + (size_t)(seq0 + 64 * (j) + pr) * 32 + pc); } while (0)
#define SWRITE(b, S) do { *(bf16x8*)(lds + A_K0 + (b) * A_KBUF + sr * KSTR + sc * 2) = ks##S; *(bf16x8*)(lds + A_V0 + (b) * A_VBUF + vst) = vs##S; \
        if (tid < 256) *(bf16x8*)(lds + A_K0 + (b) * A_KBUF + pr * KSTR + 128 + pc * 2) = ps##S; } while (0)
#define RESC(a) do { if (__any((a) < 1.f)) { if (hi == 0) al_l[r32] = (a); LDS_WAIT(); \
        _Pragma("unroll") for (int d = 0; d < 2; ++d) _Pragma("unroll") for (int r = 0; r < 16; ++r) o[d][r] *= al_l[crow(r, hi)]; LDS_WAIT(); } } while (0)
#define SBAR() __builtin_amdgcn_sched_barrier(0)
    const unsigned char* K0 = lds + A_K0; const unsigned char* K1 = lds + A_K0 + A_KBUF;
    f32x16 pA0, pA1, pB0, pB1; float alA, alB; bf16x8 pa0, pa1, pa2, pa3;
    SLOAD(E, 0); SWRITE(0, E); __syncthreads();
    mla_qkt(pA0, pA1, K0, qr, r32, hi); mla_partialSM(pA0, pA1, m_reg, alA);
    SLOAD(O, 1); SLOAD(E, 2); SWRITE(1, O); __syncthreads();
    for (int j = 1; j + 1 < NT; j += 2) {
        SBAR(); mla_qkt(pB0, pB1, K1, qr, r32, hi);
        mla_finishSM(pA0, pA1, alA, l_reg, pa0, pa1, pa2, pa3); SBAR();
        SLOAD(O, j + 2); SBAR();
        pv_one<0>(o[0], vb0, pa0, pa1, pa2, pa3); pv_one<1>(o[1], vb0, pa0, pa1, pa2, pa3); mla_partialSM(pB0, pB1, m_reg, alB);
        __syncthreads(); SWRITE(0, E);
        RESC(alB); __syncthreads();
        SBAR(); mla_qkt(pA0, pA1, K0, qr, r32, hi);
        mla_finishSM(pB0, pB1, alB, l_reg, pa0, pa1, pa2, pa3); SBAR();
        if (j + 3 < NT) SLOAD(E, j + 3); SBAR();
        pv_one<0>(o[0], vb0 + A_VBUF, pa0, pa1, pa2, pa3); pv_one<1>(o[1], vb0 + A_VBUF, pa0, pa1, pa2, pa3); mla_partialSM(pA0, pA1, m_reg, alA);
        __syncthreads(); SWRITE(1, O);
        RESC(alA); __syncthreads();
    }
    SBAR(); mla_qkt(pB0, pB1, K1, qr, r32, hi);
    mla_finishSM(pA0, pA1, alA, l_reg, pa0, pa1, pa2, pa3); SBAR();
    pv_one<0>(o[0], vb0, pa0, pa1, pa2, pa3); pv_one<1>(o[1], vb0, pa0, pa1, pa2, pa3); mla_partialSM(pB0, pB1, m_reg, alB);
    RESC(alB);
    mla_finishSM(pB0, pB1, alB, l_reg, pa0, pa1, pa2, pa3); SBAR();
    pv_one<0>(o[0], vb0 + A_VBUF, pa0, pa1, pa2, pa3); pv_one<1>(o[1], vb0 + A_VBUF, pa0, pa1, pa2, pa3);
#undef SLOAD
#undef SWRITE
#undef RESC
#undef SBAR
    if (hi == 0) li_l[r32] = l_reg; LDS_WAIT();
    float rli[16];
#pragma unroll
    for (int r = 0; r < 16; ++r) rli[r] = __builtin_amdgcn_rcpf(li_l[crow(r, hi)]);
    if (dry) Gp = (bf16_t*)(ws + WS_END) + h * 64 - (size_t)(seq0 + t0) * ldg + (size_t)((rb & 7) * 256) * ldg;
    bf16_t* Gw = Gp + (size_t)(seq0 + t0 + wid * 32) * ldg + r32;
#pragma unroll
    for (int r = 0; r < 16; ++r) { const int orow = crow(r, hi);
#pragma unroll
        for (int d0 = 0; d0 < 2; ++d0) { bf16_t* gp = Gw + (size_t)orow * ldg + d0 * 32; const float g = bf2f(*gp);
            const float sg = g * __builtin_amdgcn_rcpf(1.f + __builtin_amdgcn_exp2f(-g * LOG2E));
            *gp = (bf16_t)(cvt_pk_bf16(o[d0][r] * rli[r] * sg, 0.f) & 0xffffu); } }
    LDS_WAIT();
    __syncthreads();
}

__device__ __forceinline__ int v_rd_base_kp(int lane) { return ((lane & 3) << 3) | (((lane >> 2) & 3) << 6) | (((lane >> 4) & 1) << 5) | (((lane >> 5) & 1) << 10); }
constexpr int v_rd_off_kp(int d0, int ks, int rows47) { return d0 * 512 + ks * 2048 + rows47 * 256; }
__device__ __forceinline__ void pv_both_kp(f32x16& o0, f32x16& o1, int vb, bf16x8 pa0, bf16x8 pa1, bf16x8 pa2, bf16x8 pa3) {
    const s16x4 l0 = tr_read<v_rd_off_kp(0, 0, 0)>(vb), h0 = tr_read<v_rd_off_kp(0, 0, 1)>(vb), l1 = tr_read<v_rd_off_kp(0, 1, 0)>(vb), h1 = tr_read<v_rd_off_kp(0, 1, 1)>(vb);
    const s16x4 l2 = tr_read<v_rd_off_kp(0, 2, 0)>(vb), h2 = tr_read<v_rd_off_kp(0, 2, 1)>(vb), l3 = tr_read<v_rd_off_kp(0, 3, 0)>(vb), h3 = tr_read<v_rd_off_kp(0, 3, 1)>(vb);
    const s16x4 m0 = tr_read<v_rd_off_kp(1, 0, 0)>(vb), n0 = tr_read<v_rd_off_kp(1, 0, 1)>(vb), m1 = tr_read<v_rd_off_kp(1, 1, 0)>(vb), n1 = tr_read<v_rd_off_kp(1, 1, 1)>(vb);
    const s16x4 m2 = tr_read<v_rd_off_kp(1, 2, 0)>(vb), n2 = tr_read<v_rd_off_kp(1, 2, 1)>(vb), m3 = tr_read<v_rd_off_kp(1, 3, 0)>(vb), n3 = tr_read<v_rd_off_kp(1, 3, 1)>(vb);
    asm volatile("s_waitcnt lgkmcnt(8)" ::: "memory"); __builtin_amdgcn_sched_barrier(0);
#define PK(L, H) (bf16x8){L[0], L[1], L[2], L[3], H[0], H[1], H[2], H[3]}
    o0 = __builtin_amdgcn_mfma_f32_32x32x16_bf16(pa0, PK(l0, h0), o0, 0, 0, 0);
    o0 = __builtin_amdgcn_mfma_f32_32x32x16_bf16(pa1, PK(l1, h1), o0, 0, 0, 0);
    o0 = __builtin_amdgcn_mfma_f32_32x32x16_bf16(pa2, PK(l2, h2), o0, 0, 0, 0);
    o0 = __builtin_amdgcn_mfma_f32_32x32x16_bf16(pa3, PK(l3, h3), o0, 0, 0, 0);
    asm volatile("s_waitcnt lgkmcnt(0)" ::: "memory"); __builtin_amdgcn_sched_barrier(0);
    o1 = __builtin_amdgcn_mfma_f32_32x32x16_bf16(pa0, PK(m0, n0), o1, 0, 0, 0);
    o1 = __builtin_amdgcn_mfma_f32_32x32x16_bf16(pa1, PK(m1, n1), o1, 0, 0, 0);
    o1 = __builtin_amdgcn_mfma_f32_32x32x16_bf16(pa2, PK(m2, n2), o1, 0, 0, 0);
    o1 = __builtin_amdgcn_mfma_f32_32x32x16_bf16(pa3, PK(m3, n3), o1, 0, 0, 0);
#undef PK
}
__device__ __forceinline__ void mla_softmax_seg(f32x16& p0, f32x16& p1, float& m_reg, float& l_reg, float& alpha, bf16x8& pa0, bf16x8& pa1, bf16x8& pa2, bf16x8& pa3) {
    float pmax = p0[0];
#pragma unroll
    for (int r = 1; r < 16; ++r) pmax = fmaxf(pmax, p0[r]);
#pragma unroll
    for (int r = 0; r < 16; ++r) pmax = fmaxf(pmax, p1[r]);
    { auto rr = __builtin_amdgcn_permlane32_swap(__float_as_uint(pmax), __float_as_uint(pmax), false, false); pmax = fmaxf(__uint_as_float(rr[0]), __uint_as_float(rr[1])); }
    float mn;
    if (__builtin_expect(__all(pmax - m_reg <= THR2), 1)) { mn = m_reg; alpha = 1.f; }
    else { mn = fmaxf(m_reg, pmax); alpha = __builtin_amdgcn_exp2f(m_reg - mn); m_reg = mn; }
#pragma unroll
    for (int r = 0; r < 16; ++r) { p0[r] = __builtin_amdgcn_exp2f(p0[r] - mn); p1[r] = __builtin_amdgcn_exp2f(p1[r] - mn); }
    float ps = 0.f;
#pragma unroll
    for (int r = 0; r < 16; ++r) ps += p0[r];
#pragma unroll
    for (int r = 0; r < 16; ++r) ps += p1[r];
    { auto rr = __builtin_amdgcn_permlane32_swap(__float_as_uint(ps), __float_as_uint(ps), false, false); ps = __uint_as_float(rr[0]) + __uint_as_float(rr[1]); }
    l_reg = l_reg * alpha + ps;
#define PK4(Pv, BASE, OUT) do { unsigned a0 = cvt_pk_bf16(Pv[BASE + 0], Pv[BASE + 1]), a1 = cvt_pk_bf16(Pv[BASE + 2], Pv[BASE + 3]);   \
    unsigned b0_ = cvt_pk_bf16(Pv[BASE + 4], Pv[BASE + 5]), b1_ = cvt_pk_bf16(Pv[BASE + 6], Pv[BASE + 7]);                              \
    auto r0 = __builtin_amdgcn_permlane32_swap(a0, b0_, false, false); auto r1 = __builtin_amdgcn_permlane32_swap(a1, b1_, false, false); \
    u32x4 w = {r0[0], r1[0], r0[1], r1[1]}; OUT = *reinterpret_cast<bf16x8*>(&w); } while (0)
    PK4(p0, 0, pa0); PK4(p0, 8, pa1); PK4(p1, 0, pa2); PK4(p1, 8, pa3);
#undef PK4
}
__device__ __forceinline__ void mla_unit2(const Params& P, unsigned char* lds, int h, int rb, int grp, bool dry = false) {
    const int tid = opaque_tid(), lane = tid & 63, r32 = lane & 31, hi = lane >> 5; const int wid = __builtin_amdgcn_readfirstlane(tid >> 6);
    const int hoff = wid >> 2;
    unsigned char* ws = P.ws;
    const int l = grp ? 16384 : 2048; const size_t rowoff = grp ? M_A : 0; const int m0 = rb * 256; const int seq0 = m0 & ~(l - 1), t0 = m0 - seq0;
    const bf16_t* Qp = (const bf16_t*)(ws + WS_QG) + h * 96; const bf16_t* Kp = (const bf16_t*)(ws + WS_KG) + h * 64; const bf16_t* Vp = (const bf16_t*)(ws + WS_VG) + h * 64;
    const bf16_t* Kpe = (const bf16_t*)(ws + WS_KPE) + rowoff * 32; bf16_t* Gp = (bf16_t*)(ws + WS_U1) + rowoff * OD_INP + 416 + h * 64; const int ldg = OD_INP;
    const int NT = l >> 6;
    bf16x8 qr[6];
    { const bf16_t* Qw = Qp + (size_t)(seq0 + t0 + wid * 32 + r32) * 1536 + hi * 8;
#pragma unroll
      for (int d0 = 0; d0 < 6; ++d0) qr[d0] = *(const bf16x8*)(Qw + d0 * 16); }
    float* wsf = (float*)(lds + A_WS) + wid * 64; float* li_l = wsf; float* al_l = wsf + 32;
    float l_reg = 0.f, alpha = 1.f; f32x16 o[2] = {}; f32x16 p0, p1; bf16x8 pa0, pa1, pa2, pa3; f32x16 negm = {}; bool first = true;
    const int sr = tid >> 3, sc = (tid & 7) * 8, pr = (tid & 255) >> 2, pc = (tid & 3) * 8;
    const int vst = v_st(sr, sc);
    const int vb0 = (int)(uintptr_t)(lds + A_V0) + v_rd_base_kp(lane);
    const unsigned char* K0 = lds + A_K0; const unsigned char* K1 = lds + A_K0 + A_KBUF;
    unsigned char* kwE = lds + A_K0 + (hoff ? 0 : A_KBUF); unsigned char* vwE = lds + A_V0 + (hoff ? A_VBUF : 0);
    unsigned char* kwO = lds + A_K0 + (hoff ? A_KBUF : 0); unsigned char* vwO = lds + A_V0 + (hoff ? 0 : A_VBUF);
    bf16x8 ksE, vsE, psE, ksO, vsO, psO;
#define SLOAD(S, t) do { const int t_ = (t); if (t_ + 1 < NT) { const size_t krow = (size_t)(seq0 + 64 * (t_ + 1) + sr); ks##S = *(const bf16x8*)(Kp + krow * 1024 + sc); \
            ps##S = *(const bf16x8*)(Kpe + (size_t)(seq0 + 64 * (t_ + 1) + pr) * 32 + pc); } \
        if (t_ < NT) { const size_t vrow = (size_t)(seq0 + 64 * t_ + sr); vs##S = *(const bf16x8*)(Vp + vrow * 1024 + sc); } } while (0)
#define SWRITE(S, t, kw, vw) do { const int t_ = (t); if (t_ + 1 < NT) { *(bf16x8*)((kw) + sr * KSTR + sc * 2) = ks##S; if (tid < 256) *(bf16x8*)((kw) + pr * KSTR + 128 + pc * 2) = ps##S; } \
        if (t_ < NT) *(bf16x8*)((vw) + vst) = vs##S; } while (0)
#define RESC(a) do { if (__any((a) < 1.f)) { if (hi == 0) al_l[r32] = (a); LDS_WAIT(); \
        _Pragma("unroll") for (int d = 0; d < 2; ++d) _Pragma("unroll") for (int r = 0; r < 16; ++r) o[d][r] *= al_l[crow(r, hi)]; LDS_WAIT(); } } while (0)
#define HBAR() do { asm volatile("s_waitcnt lgkmcnt(0)" ::: "memory"); __builtin_amdgcn_s_barrier(); asm volatile("" ::: "memory"); } while (0)
#define SBAR() __builtin_amdgcn_sched_barrier(0)
    { const bf16x8 k0v = *(const bf16x8*)(Kp + (size_t)(seq0 + sr) * 1024 + sc); const bf16x8 p0v = *(const bf16x8*)(Kpe + (size_t)(seq0 + pr) * 32 + pc);
      SLOAD(E, hoff); if (hoff) SLOAD(O, 0);
      *(bf16x8*)(lds + A_K0 + sr * KSTR + sc * 2) = k0v; if (tid < 256) *(bf16x8*)(lds + A_K0 + pr * KSTR + 128 + pc * 2) = p0v; }
    HBAR();
    if (hoff) { SWRITE(O, 0, kwO, vwO); HBAR(); }
    for (int i = 0; i < NT; i += 2) {
        SLOAD(O, i + 1 + hoff); SBAR();
        mla_qkt_neg(p0, p1, negm, K0, qr, r32, hi);
        if (i > 0) { pv_both_kp(o[0], o[1], vb0 + A_VBUF, pa0, pa1, pa2, pa3); }
        HBAR();
        __builtin_amdgcn_s_setprio(1);
        SWRITE(E, i + hoff, kwE, vwE); SBAR();
        mla_softmax_rel_kp(p0, p1, negm, first, l_reg, alpha, pa0, pa1, pa2, pa3); first = false; RESC(alpha);
        __builtin_amdgcn_s_setprio(0);
        HBAR();
        SLOAD(E, i + 2 + hoff); SBAR();
        mla_qkt_neg(p0, p1, negm, K1, qr, r32, hi);
        pv_both_kp(o[0], o[1], vb0, pa0, pa1, pa2, pa3);
        HBAR();
        __builtin_amdgcn_s_setprio(1);
        SWRITE(O, i + 1 + hoff, kwO, vwO); SBAR();
        mla_softmax_rel_kp(p0, p1, negm, first, l_reg, alpha, pa0, pa1, pa2, pa3); first = false; RESC(alpha);
        __builtin_amdgcn_s_setprio(0);
        HBAR();
    }
    if (dry) Gp = (bf16_t*)(ws + WS_END) + h * 64 - (size_t)(seq0 + t0) * ldg + (size_t)((rb & 7) * 256) * ldg;
    bf16_t* Gw = Gp + (size_t)(seq0 + t0 + wid * 32) * ldg + r32;
    bf16_t gq[32];
#pragma unroll
    for (int r = 0; r < 16; ++r) { const int orow = crow(r, hi); gq[2 * r] = Gw[(size_t)orow * ldg]; gq[2 * r + 1] = Gw[(size_t)orow * ldg + 32]; }
    pv_both_kp(o[0], o[1], vb0 + A_VBUF, pa0, pa1, pa2, pa3);
    HBAR();
    if (!hoff) HBAR();
#undef SLOAD
#undef SWRITE
#undef RESC
#undef HBAR
#undef SBAR
    if (hi == 0) li_l[r32] = l_reg; LDS_WAIT();
    float rli[16];
#pragma unroll
    for (int r = 0; r < 16; ++r) rli[r] = __builtin_amdgcn_rcpf(li_l[crow(r, hi)]);
#pragma unroll
    for (int r = 0; r < 16; ++r) { const int orow = crow(r, hi);
#pragma unroll
        for (int d0 = 0; d0 < 2; ++d0) { bf16_t* gp = Gw + (size_t)orow * ldg + d0 * 32; const float g = bf2f(gq[2 * r + d0]);
            const float sg = g * __builtin_amdgcn_rcpf(1.f + __builtin_amdgcn_exp2f(-g * LOG2E));
            *gp = (bf16_t)(cvt_pk_bf16(o[d0][r] * rli[r] * sg, 0.f) & 0xffffu); } }
    LDS_WAIT();
}

__device__ __forceinline__ void transpose_tile(const float* W, int K, int N, bf16_t* WT, LAS float* scr, int k0, int n0, int lane, const float* kscale, float cscale) {
#pragma unroll 8
    for (int i = 0; i < 32; ++i) { const int kk = 2 * i + (lane >> 5); float s = cscale; if (kscale) s *= kscale[k0 + kk];
        scr[kk * 33 + (lane & 31)] = W[(size_t)(k0 + kk) * N + n0 + (lane & 31)] * s; }
    LDS_WAIT(); asm volatile("" ::: "memory");
    const int c = lane & 7;
#pragma unroll
    for (int j = 0; j < 4; ++j) { const int n = (lane >> 3) + 8 * j; const LAS float* s = scr + (8 * c) * 33 + n;
        u32x4 o; o.x = cvt_pk_bf16(s[0 * 33], s[1 * 33]); o.y = cvt_pk_bf16(s[2 * 33], s[3 * 33]); o.z = cvt_pk_bf16(s[4 * 33], s[5 * 33]); o.w = cvt_pk_bf16(s[6 * 33], s[7 * 33]);
        *(u32x4*)(WT + (size_t)(n0 + n) * K + k0 + 8 * c) = o; }
    LDS_WAIT(); asm volatile("" ::: "memory");
}

__device__ __forceinline__ void phase0(const Params& P, unsigned char* lds) {
    const int tid = opaque_tid(), lane = tid & 63, wave = tid >> 6, G = gridDim.x;
    const int gw = blockIdx.x * 8 + wave, NGW = G * 8, gtid = blockIdx.x * 512 + tid, NTH = G * 512;
    unsigned char* ws = P.ws;
    { float2* rope = (float2*)(ws + WS_ROPE);
      for (int i = gtid; i < 16384 * 16; i += NTH) { const int pos = i >> 4, j = i & 15;
          const float invf = (float)exp2(-(double)j * (13.287712379549449 / 16.0)); const float ang = (float)pos * invf;
          double rev = (double)ang * 0.15915494309189535; rev -= floor(rev); const float rv = (float)rev;
          rope[i] = make_float2(__builtin_amdgcn_cosf(rv), __builtin_amdgcn_sinf(rv)); } }
    { u32x4* z = (u32x4*)((bf16_t*)(ws + WS_WIN1) + (size_t)OD_IN * DM); const int n16 = (OD_INP - OD_IN) * DM * 2 / 16;
      for (int i = gtid; i < n16; i += NTH) z[i] = (u32x4){0u, 0u, 0u, 0u}; }
    { LAS float* scr = (LAS float*)(LAS unsigned char*)lds + wave * (64 * 33);
      constexpr int I0 = 16 * 104, I1 = 16 * 32, I2 = 16 * 45, I3 = 4 * 48, I4 = 2 * 64, I5 = 16 * 32, NIT = I0 + I1 + I2 + I3 + I4 + I5;
      for (int it = gw; it < NIT; it += NGW) { int r = it;
          if (r < I0) { const int kb = r / 104, nb = r % 104, n0 = nb * 32; const float cs = (n0 < 512 || (n0 >= 1536 && n0 < 2048)) ? QS64 : 1.f;
              transpose_tile(P.ev_w_in, 1024, EV_IN, (bf16_t*)(ws + WS_WIN0), scr, kb * 64, n0, lane, nullptr, cs); continue; } r -= I0;
          if (r < I1) { transpose_tile(P.ev_w_out, 1024, 1024, (bf16_t*)(ws + WS_WOUT0), scr, (r / 32) * 64, (r % 32) * 32, lane, nullptr, 1.f); continue; } r -= I1;
          if (r < I2) { transpose_tile(P.mla_w_in, 1024, OD_IN, (bf16_t*)(ws + WS_WIN1), scr, (r / 45) * 64, (r % 45) * 32, lane, nullptr, 1.f); continue; } r -= I2;
          if (r < I3) { transpose_tile(P.mla_w_qb, 256, 1536, (bf16_t*)(ws + WS_WQB), scr, (r / 48) * 64, (r % 48) * 32, lane, P.mla_q_norm, 1.f); continue; } r -= I3;
          if (r < I4) { transpose_tile(P.mla_w_kvb, 128, 2048, (bf16_t*)(ws + WS_WKVB), scr, (r / 64) * 64, (r % 64) * 32, lane, P.mla_kv_norm, 1.f); continue; } r -= I4;
          transpose_tile(P.mla_w_out, 1024, 1024, (bf16_t*)(ws + WS_WOUT1), scr, (r / 32) * 64, (r % 32) * 32, lane, nullptr, 1.f); } }
    __syncthreads();
    { float* cs = (float*)lds; float* mod = (float*)(ws + WS_MOD);
      for (int u = blockIdx.x; u < 192; u += G) { const int cc = u % 12, kc = u / 12; const int col = cc * 512 + tid, layer = col / 3072, n = col % 3072;
          __syncthreads();
          for (int i = tid; i < 18 * 64; i += 512) { const int bi = i >> 6, k = kc * 64 + (i & 63); const float c = bi < 16 ? P.c_p[bi * DM + k] : P.c_s[(bi - 16) * DM + k];
              cs[i] = c / (1.f + __expf(-c)); }
          __syncthreads();
          float acc[18];
#pragma unroll
          for (int b = 0; b < 18; ++b) acc[b] = 0.f;
          const float* w = P.ada_w + ((size_t)layer * 1024 + kc * 64) * 3072 + n;
          for (int k0 = 0; k0 < 64; k0 += 8) { float wv[8];
#pragma unroll
              for (int kk = 0; kk < 8; ++kk) wv[kk] = w[(size_t)(k0 + kk) * 3072];
#pragma unroll
              for (int kk = 0; kk < 8; ++kk)
#pragma unroll
                  for (int b = 0; b < 18; ++b) acc[b] += cs[b * 64 + k0 + kk] * wv[kk]; }
          const float bias = (kc == 0) ? P.ada_b[layer * 3072 + n] : 0.f;
#pragma unroll
          for (int b = 0; b < 18; ++b) atomicAdd(mod + (size_t)(b * 2 + layer) * 3072 + n, acc[b] + bias); }
      __syncthreads(); }
}

constexpr int NROW = 4;
__device__ __forceinline__ void norm_mod_phase(const Params& P, int layer, bool from_out, bf16_t* H) {
    const int tid = opaque_tid(), lane = tid & 63, wave = tid >> 6; const int gw = blockIdx.x * 8 + wave, NGW = gridDim.x * 8;
    const float* modbuf = (const float*)(P.ws + WS_MOD); const float* gn = P.norm_g + layer * DM;
    for (int m = gw; m < M_TOK; m += NROW * NGW) {
        f32x4 v[NROW][4]; int mr[NROW]; bool ok[NROW];
#pragma unroll
        for (int q = 0; q < NROW; ++q) { const int mq = m + q * NGW; ok[q] = mq < M_TOK; mr[q] = ok[q] ? mq : m;
            const float* x = from_out ? P.out + (size_t)mr[q] * DM : (mr[q] < M_A ? P.x_p + (size_t)mr[q] * DM : P.x_s + (size_t)(mr[q] - M_A) * DM);
#pragma unroll
            for (int j = 0; j < 4; ++j) v[q][j] = __builtin_nontemporal_load((const f32x4*)(x + 4 * lane + 256 * j)); }
        float rs[NROW];
#pragma unroll
        for (int q = 0; q < NROW; ++q) { float sq = 0.f;
#pragma unroll
            for (int j = 0; j < 4; ++j) sq += (v[q][j][0] * v[q][j][0] + v[q][j][1] * v[q][j][1]) + (v[q][j][2] * v[q][j][2] + v[q][j][3] * v[q][j][3]);
            rs[q] = rsqrtf(wave_sum(sq) * (1.0f / DM) + EPS); }
#pragma unroll
        for (int j = 0; j < 4; ++j) { const int c = 4 * lane + 256 * j; const f32x4 g = *(const f32x4*)(gn + c);
#pragma unroll
            for (int q = 0; q < NROW; ++q) { const float* mod = modbuf + (size_t)(batch_of_row(mr[q]) * 2 + layer) * 3072;
                const f32x4 sh = *(const f32x4*)(mod + c), sc = *(const f32x4*)(mod + 1024 + c); const f32x4 hv = v[q][j] * rs[q] * g * (sc + 1.0f) + sh;
                u32x2 w; w.x = cvt_pk_bf16(hv[0], hv[1]); w.y = cvt_pk_bf16(hv[2], hv[3]); if (ok[q]) *(u32x2*)(H + (size_t)mr[q] * DM + c) = w; } }
    }
}
__device__ __forceinline__ void final_norm_phase(const Params& P) {
    const int tid = opaque_tid(), lane = tid & 63, wave = tid >> 6; const int gw = blockIdx.x * 8 + wave, NGW = gridDim.x * 8;
    for (int m = gw; m < M_TOK; m += NROW * NGW) {
        f32x4 v[NROW][4]; int mr[NROW]; bool ok[NROW];
#pragma unroll
        for (int q = 0; q < NROW; ++q) { const int mq = m + q * NGW; ok[q] = mq < M_TOK; mr[q] = ok[q] ? mq : m; const float* x = P.out + (size_t)mr[q] * DM;
#pragma unroll
            for (int j = 0; j < 4; ++j) v[q][j] = __builtin_nontemporal_load((const f32x4*)(x + 4 * lane + 256 * j)); }
        float rs[NROW];
#pragma unroll
        for (int q = 0; q < NROW; ++q) { float sq = 0.f;
#pragma unroll
            for (int j = 0; j < 4; ++j) sq += (v[q][j][0] * v[q][j][0] + v[q][j][1] * v[q][j][1]) + (v[q][j][2] * v[q][j][2] + v[q][j][3] * v[q][j][3]);
            rs[q] = rsqrtf(wave_sum(sq) * (1.0f / DM) + EPS); }
#pragma unroll
        for (int j = 0; j < 4; ++j) { const int c = 4 * lane + 256 * j; const f32x4 g = *(const f32x4*)(P.final_g + c);
#pragma unroll
            for (int q = 0; q < NROW; ++q) if (ok[q]) __builtin_nontemporal_store(v[q][j] * rs[q] * g, (f32x4*)(P.out + (size_t)mr[q] * DM + c)); }
    }
}

__global__ void __launch_bounds__(512, 2) mega_fwd(Params Pk) {
    extern __shared__ __attribute__((aligned(16))) unsigned char lds[];
    cg::grid_group grid = cg::this_grid();
    LAS unsigned char* ldsl = (LAS unsigned char*)lds;
    const int G = gridDim.x, bx = blockIdx.x;
    typedef const __attribute__((address_space(4))) Params* KP;
#if defined(__HIP_DEVICE_COMPILE__)
#define PHASE_LOADP() KP kp_ = (KP)__builtin_amdgcn_kernarg_segment_ptr(); asm volatile("" : "+s"(kp_)); Params P; __builtin_memcpy(&P, kp_, sizeof(Params))
#else
#define PHASE_LOADP() const Params P = Pk
#endif
#define PHASE_ARGS() PHASE_LOADP(); unsigned char* ws = P.ws; \
    const float* modbuf = (const float*)(ws + WS_MOD); const float2* rope = (const float2*)(ws + WS_ROPE); (void)modbuf; (void)rope

    volatile LAS unsigned* bst = (volatile LAS unsigned*)(ldsl + 132096);
    if (threadIdx.x < 4) bst[threadIdx.x] = 0u;
    __syncthreads();
    { PHASE_ARGS(); (void)xcd_barrier_post((unsigned*)(ws + WS_BAR), bst); }
#define GRID_BAR() do { PHASE_ARGS(); XcdBarrier xb_; xb_.bar = (unsigned*)(ws + WS_BAR); xb_.x = xb_xcc_id(); xb_.st = (volatile LAS unsigned*)(ldsl + 132096); xcd_barrier(xb_); } while (0)
    { PHASE_ARGS(); phase0(P, lds); }
    grid.sync();
    { PHASE_ARGS(); norm_mod_phase(P, 0, false, (bf16_t*)P.out); }
    GRID_BAR();
    { PHASE_ARGS(); pg8::Gemm g{(const bf16_t*)P.out, (const bf16_t*)(ws + WS_WIN0), M_TOK, EV_IN, DM, DM}; pg8::StaticOrder S; S.init(M_TOK, EV_IN, G, bx);
      pg8::EpiBf16 E{(bf16_t*)(ws + WS_U0), EV_IN};
      pg8::gemm_phase<pg8::EpiBf16, pg8::StaticOrder, true, true>(ldsl, g, S, E); }
    GRID_BAR();
    for (int u = bx; u < 4096; u += G) { PHASE_ARGS(); if (u < 2048) attn_unit<0>(P, lds, u >> 8, u & 255, 0); else attn_unit<1>(P, lds, (u - 2048) >> 8, u & 255, 0); }
    GRID_BAR();
    { PHASE_ARGS(); pg8::Gemm g{(const bf16_t*)(ws + WS_U0) + 2304, (const bf16_t*)(ws + WS_WOUT0), M_TOK, DM, DM, EV_IN}; pg8::StaticOrder S; S.init(M_TOK, DM, G, bx);
      pg8::EpiGateRes E{P.x_p, P.x_s, P.out, modbuf, 0, 0};
      pg8::gemm_phase<pg8::EpiGateRes, pg8::StaticOrder, true, true>(ldsl, g, S, E); }
    GRID_BAR();
    { PHASE_ARGS(); norm_mod_phase(P, 1, true, (bf16_t*)(ws + WS_H1)); }
    GRID_BAR();
    { PHASE_ARGS(); pg8::Gemm g{(const bf16_t*)(ws + WS_H1), (const bf16_t*)(ws + WS_WIN1), M_TOK, OD_INP, DM, DM}; pg8::StaticOrder S; S.init(M_TOK, OD_INP, G, bx);
      pg8::EpiU1 E{(bf16_t*)(ws + WS_U1), (float*)(ws + WS_SSQQ), (float*)(ws + WS_SSQKV), (bf16_t*)(ws + WS_KPE), rope};
      pg8::gemm_phase<pg8::EpiU1, pg8::StaticOrder, true, true>(ldsl, g, S, E); }
    GRID_BAR();
    for (int grp = 0; grp < 2; ++grp) {
        const int row_off = grp * M_A;
        { PHASE_ARGS(); pg8::Gemm g{(const bf16_t*)(ws + WS_U1) + (size_t)row_off * OD_INP, (const bf16_t*)(ws + WS_WQB), M_A, 1536, 256, OD_INP}; pg8::StaticOrder S; S.init(M_A, 1536, G, bx);
          pg8::EpiQ E{(bf16_t*)(ws + WS_QG), (const float*)(ws + WS_SSQQ), rope, row_off};
          pg8::gemm_phase<pg8::EpiQ, pg8::StaticOrder, true, true>(ldsl, g, S, E); }
        { PHASE_ARGS(); pg8::Gemm g{(const bf16_t*)(ws + WS_U1) + (size_t)row_off * OD_INP + 256, (const bf16_t*)(ws + WS_WKVB), M_A, 2048, 128, OD_INP}; pg8::StaticOrder S; S.init(M_A, 2048, G, bx);
          pg8::EpiKV E{(bf16_t*)(ws + WS_KG), (bf16_t*)(ws + WS_VG), (const float*)(ws + WS_SSQKV), row_off};
          pg8::gemm_phase<pg8::EpiKV, pg8::StaticOrder, true, true>(ldsl, g, S, E); }
        GRID_BAR();
        for (int u = bx; u < 2048; u += G) { PHASE_ARGS(); mla_unit2(P, lds, u >> 7, u & 127, grp); }
        GRID_BAR();
    }
    { PHASE_ARGS(); pg8::Gemm g{(const bf16_t*)(ws + WS_U1) + 416, (const bf16_t*)(ws + WS_WOUT1), M_TOK, DM, DM, OD_INP}; pg8::StaticOrder S; S.init(M_TOK, DM, G, bx);
      pg8::EpiGateRes E{P.x_p, P.x_s, P.out, modbuf, 1, 1};
      pg8::gemm_phase<pg8::EpiGateRes, pg8::StaticOrder, true, true>(ldsl, g, S, E); }
    GRID_BAR();
    { PHASE_ARGS(); final_norm_phase(P); }
}

extern "C" void kernel_launch(void* const* d_in, const int* in_sizes, int n_in, void* d_out, int out_size, void* d_ws, size_t ws_size, hipStream_t stream) {
    static int grid = 0;
    if (grid == 0) {
        if (n_in != 19 || out_size != 2 * M_A * DM || ws_size < WS_END) { fprintf(stderr, "kernel_launch: unexpected shapes (n_in %d out %d ws %zu)\n", n_in, out_size, ws_size); grid = -1; return; }
        int dev = 0, cus = 0, per_cu = 0;
        hipGetDevice(&dev); hipDeviceGetAttribute(&cus, hipDeviceAttributeMultiprocessorCount, dev);
        if (hipFuncSetAttribute((const void*)mega_fwd, hipFuncAttributeMaxDynamicSharedMemorySize, LDS_BYTES) != hipSuccess) { fprintf(stderr, "kernel_launch: hipFuncSetAttribute failed\n"); grid = -1; return; }
        if (hipOccupancyMaxActiveBlocksPerMultiprocessor(&per_cu, (const void*)mega_fwd, 512, LDS_BYTES) != hipSuccess || per_cu < 1) { fprintf(stderr, "kernel_launch: occupancy query gave %d\n", per_cu); per_cu = 1; }
        (void)hipGetLastError();
        grid = cus * 1;
    }
    if (grid < 0) return;
    hipMemsetAsync(d_ws, 0, WS_ZERO_BYTES, stream);
    Params p{};
    p.x_p = (const float*)d_in[0]; p.x_s = (const float*)d_in[1]; p.c_p = (const float*)d_in[2]; p.c_s = (const float*)d_in[3];
    p.ada_w = (const float*)d_in[4]; p.ada_b = (const float*)d_in[5]; p.norm_g = (const float*)d_in[6]; p.t5_bias = (const float*)d_in[7];
    p.ev_w_in = (const float*)d_in[8]; p.na_rpb = (const float*)d_in[9]; p.wb_sink = (const float*)d_in[10]; p.ev_w_out = (const float*)d_in[11];
    p.mla_w_in = (const float*)d_in[12]; p.mla_q_norm = (const float*)d_in[13]; p.mla_w_qb = (const float*)d_in[14]; p.mla_kv_norm = (const float*)d_in[15];
    p.mla_w_kvb = (const float*)d_in[16]; p.mla_w_out = (const float*)d_in[17]; p.final_g = (const float*)d_in[18];
    p.out = (float*)d_out; p.ws = (unsigned char*)d_ws;
    void* args[] = {&p};
    hipError_t e = hipLaunchCooperativeKernel((const void*)mega_fwd, dim3(grid), dim3(512), args, LDS_BYTES, stream);
    if (e != hipSuccess) fprintf(stderr, "kernel_launch: cooperative launch failed: %s (grid %d)\n", hipGetErrorString(e), grid);
}
```

```cpp
#include <hip/hip_runtime.h>
#include <hip/hip_cooperative_groups.h>
#include <cstdio>
#include <cstdint>
namespace cg = cooperative_groups;

#define LAS __attribute__((address_space(3)))
typedef unsigned short bf16_t;
typedef short bf16x8 __attribute__((ext_vector_type(8)));
typedef short s16x4 __attribute__((ext_vector_type(4)));
typedef float f32x4 __attribute__((ext_vector_type(4)));
typedef float f32x16 __attribute__((ext_vector_type(16)));
typedef unsigned u32x4 __attribute__((ext_vector_type(4)));
typedef unsigned u32x2 __attribute__((ext_vector_type(2)));

constexpr int DM = 1024, M_TOK = 65536, M_A = 32768;
constexpr int EV_IN = 3328, OD_IN = 1440, OD_INP = 1536;
constexpr float EPS = 1e-6f, LOG2E = 1.4426950408889634f;
constexpr float QS64 = 0.125f * LOG2E;
constexpr float QS96 = 0.10206207261596577f * LOG2E;

constexpr size_t MiB = 1u << 20;
constexpr size_t WS_SSQQ = 0, WS_SSQKV = 256 * 1024, WS_MOD = 512 * 1024, WS_ZERO_BYTES = MiB;
constexpr size_t WS_BAR = 960 * 1024;
constexpr size_t WS_ROPE = 1 * MiB;
constexpr size_t WS_KPE = 3 * MiB;
constexpr size_t WS_WIN0 = 7 * MiB;
constexpr size_t WS_WOUT0 = WS_WIN0 + (size_t)EV_IN * DM * 2;
constexpr size_t WS_WIN1 = WS_WOUT0 + (size_t)DM * DM * 2;
constexpr size_t WS_WQB = WS_WIN1 + (size_t)OD_INP * DM * 2;
constexpr size_t WS_WKVB = WS_WQB + (size_t)1536 * 256 * 2;
constexpr size_t WS_WOUT1 = WS_WKVB + (size_t)2048 * 128 * 2;
static_assert(WS_WOUT1 + (size_t)DM * DM * 2 <= 32 * MiB, "ws map");
constexpr size_t WS_U0 = 32 * MiB;
constexpr size_t WS_U1 = 32 * MiB;
constexpr size_t WS_H1 = 224 * MiB;
constexpr size_t WS_QG = 224 * MiB;
constexpr size_t WS_KG = 320 * MiB;
constexpr size_t WS_VG = 384 * MiB;
constexpr size_t WS_END = 448 * MiB;

constexpr int LDS_BYTES = 135168;

struct Params {
    const float *x_p, *x_s, *c_p, *c_s, *ada_w, *ada_b, *norm_g, *t5_bias, *ev_w_in, *na_rpb, *wb_sink, *ev_w_out,
                *mla_w_in, *mla_q_norm, *mla_w_qb, *mla_kv_norm, *mla_w_kvb, *mla_w_out, *final_g;
    float* out; unsigned char* ws;
};

__device__ __forceinline__ int batch_of_row(int m) { return m < M_A ? (m >> 11) : 16 + ((m - M_A) >> 14); }
__device__ __forceinline__ int pos_of_row(int m) { return m < M_A ? (m & 2047) : ((m - M_A) & 16383); }
__device__ __forceinline__ unsigned cvt_pk_bf16(float lo, float hi) { unsigned r; asm volatile("v_cvt_pk_bf16_f32 %0, %1, %2" : "=v"(r) : "v"(lo), "v"(hi)); return r; }
__device__ __forceinline__ bf16x8 pack8(const f32x16& p, int base) {
    u32x4 w = {cvt_pk_bf16(p[base + 0], p[base + 1]), cvt_pk_bf16(p[base + 2], p[base + 3]), cvt_pk_bf16(p[base + 4], p[base + 5]), cvt_pk_bf16(p[base + 6], p[base + 7])};
    return *reinterpret_cast<bf16x8*>(&w);
}
__device__ __forceinline__ float bf2f(bf16_t v) { return __uint_as_float((unsigned)v << 16); }
__device__ __forceinline__ float wave_sum(float v) {
#pragma unroll
    for (int o = 1; o < 64; o <<= 1) v += __shfl_xor(v, o);
    return v;
}
#define LDS_WAIT() asm volatile("s_waitcnt lgkmcnt(0)" ::: "memory")
__device__ __forceinline__ int opaque_tid() { int t = threadIdx.x; asm volatile("" : "+v"(t)); return t; }

__device__ const unsigned char T5_BUCKET[257] = {
15,15,15,15,15,15,15,15,15,15,15,15,15,15,15,15,15,15,15,15,15,15,15,15,15,15,15,15,15,15,15,15,15,15,15,15,15,15,14,14,14,14,14,14,14,14,14,14,14,14,14,14,14,14,14,14,14,14,14,14,14,14,14,14,14,13,13,13,13,13,13,13,13,13,13,13,13,13,13,13,13,13,13,12,12,12,12,12,12,12,12,12,12,12,12,12,12,11,11,11,11,11,11,11,11,11,10,10,10,10,10,10,10,9,9,9,9,8,8,8,8,7,6,5,4,3,2,1,0,17,18,19,20,21,22,23,24,24,24,24,25,25,25,25,26,26,26,26,26,26,26,27,27,27,27,27,27,27,27,27,28,28,28,28,28,28,28,28,28,28,28,28,28,28,29,29,29,29,29,29,29,29,29,29,29,29,29,29,29,29,29,29,30,30,30,30,30,30,30,30,30,30,30,30,30,30,30,30,30,30,30,30,30,30,30,30,30,30,30,31,31,31,31,31,31,31,31,31,31,31,31,31,31,31,31,31,31,31,31,31,31,31,31,31,31,31,31,31,31,31,31,31,31,31,31,31,31};

#define XB_TMO      128
#define XB_XCNT(j)  (256  + 64 * (j))
#define XB_XSUB(j)  (1280 + 64 * (j))
#define XB_XGEN(j)  (2304 + 64 * (j))
#define XB_TOP      3328
#define XB_TOPGEN   3392
#define XCD_BAR_WORDS 3456
#define XB_SPIN_CAP (1u << 18)

__device__ __forceinline__ unsigned xb_ld(unsigned* p)              { return __hip_atomic_load(p, __ATOMIC_RELAXED, __HIP_MEMORY_SCOPE_AGENT); }
__device__ __forceinline__ unsigned xb_add(unsigned* p, unsigned v) { return __hip_atomic_fetch_add(p, v, __ATOMIC_RELAXED, __HIP_MEMORY_SCOPE_AGENT); }
__device__ __forceinline__ unsigned xb_xcc_id() { return (unsigned)__builtin_amdgcn_s_getreg((3 << 11) | 20) & 0xFu; }
#define XB_SPIN(cond, bar) do { unsigned _sp = 0; while (cond) { __builtin_amdgcn_s_sleep(1); \
    if ((++_sp & 255u) == 0u) { if (xb_ld(&(bar)[XB_TMO])) break; if (_sp > XB_SPIN_CAP) { atomicAdd(&(bar)[XB_TMO], 1u); break; } } } } while (0)

struct XcdBarrier {
    unsigned* bar; unsigned x;
    volatile LAS unsigned* st;
};

__device__ __forceinline__ XcdBarrier xcd_barrier_post(unsigned* bar, volatile LAS unsigned* st) {
    XcdBarrier b; b.bar = bar; b.x = xb_xcc_id(); b.st = st;
    if (threadIdx.x == 0) (void)xb_add(&bar[XB_XCNT(b.x)], 1u);
    return b;
}
__device__ __forceinline__ void xcd_barrier_complete(unsigned* bar, unsigned x, unsigned& nloc, unsigned& nx) {
    const unsigned G = gridDim.x * gridDim.y * gridDim.z;
    unsigned sum, cnt, mine, sp = 0u;
    for (;;) {
        sum = 0u; cnt = 0u; mine = 0u;
#pragma unroll
        for (unsigned j = 0; j < 16; ++j) { const unsigned c = xb_ld(&bar[XB_XCNT(j)]); sum += c; cnt += (c > 0u) ? 1u : 0u; mine = (j == x) ? c : mine; }
        if (sum == G) break;
        __builtin_amdgcn_s_sleep(1);
        if ((++sp & 255u) == 0u) { if (xb_ld(&bar[XB_TMO])) break; if (sp > XB_SPIN_CAP) { atomicAdd(&bar[XB_TMO], 1u); break; } }
    }
    nloc = mine > 0u ? mine : 1u; nx = cnt > 0u ? cnt : 1u;
}

__device__ __forceinline__ void xcd_barrier(const XcdBarrier& b) {
    asm volatile("s_waitcnt vmcnt(0)" ::: "memory");
    __syncthreads();
    if (threadIdx.x == 0) {
        unsigned* bar = b.bar;
        __builtin_amdgcn_s_waitcnt(0);
        unsigned nloc = b.st[0], nx = b.st[1];
        if (nloc == 0u) { xcd_barrier_complete(bar, b.x, nloc, nx); b.st[0] = nloc; b.st[1] = nx; }
        const unsigned old = xb_add(&bar[XB_XSUB(b.x)], 1u);
        const unsigned gen = old / nloc;
        if (old + 1u == (gen + 1u) * nloc) {
            __builtin_amdgcn_fence(__ATOMIC_RELEASE, "agent");
            asm volatile("s_waitcnt vmcnt(0)" ::: "memory");
            const unsigned og = xb_add(&bar[XB_TOP], 1u);
            const unsigned tg = og / nx;
            if (og + 1u == (tg + 1u) * nx) xb_add(&bar[XB_TOPGEN], 1u);
            else XB_SPIN(xb_ld(&bar[XB_TOPGEN]) == tg, bar);
            __builtin_amdgcn_fence(__ATOMIC_ACQUIRE, "agent");
            xb_add(&bar[XB_XGEN(b.x)], 1u);
            asm volatile("s_waitcnt vmcnt(0)" ::: "memory");
        } else {
            XB_SPIN(xb_ld(&bar[XB_XGEN(b.x)]) == gen, bar);
            __builtin_amdgcn_fence(__ATOMIC_ACQUIRE, "agent");
            asm volatile("s_waitcnt vmcnt(0)" ::: "memory");
        }
    }
    __syncthreads();
}

namespace pg8 {
constexpr int BM = 256, BK = 64, HALF = 128, HTB = HALF * BK * 2, STAGE_BYTES = 8 * HTB, NXCD = 8, WGM = 8;
__host__ __device__ __forceinline__ int lds_byte(int r, int c) { const int st = (r >> 4) * 2 + (c >> 5), rr = r & 15, cc = c & 31, ob = rr * 64 + cc * 2; return st * 1024 + (ob ^ (((ob >> 9) & 1) << 5)); }
__host__ __device__ __forceinline__ void stage_rc(int b, int& R, int& C) { const int st = b / 1024, sb = b % 1024, swz = sb ^ (((sb >> 9) & 1) << 5); R = (st >> 1) * 16 + swz / 64; C = (st & 1) * 32 + (swz % 64) / 2; }
__host__ __device__ __forceinline__ int perm32(int rho) { const int n = rho >> 4, i = rho & 15; return 8 * (i >> 2) + 4 * n + (i & 3); }
struct Unit { int pm, pn; };
struct Gemm { const bf16_t* A; const bf16_t* Bt; int M, N, K, lda; };
struct StaticOrder {
    int nM, nN, nwg, G, c;
    __host__ __device__ void init(int M, int N, int G_, int c_) { nM = M / BM; nN = N / BM; nwg = nM * nN; G = G_; c = c_; }
    __host__ __device__ bool next(int i, Unit& u) const {
        const long L = (long)i * G + c; if (L >= nwg) return false;
        int wgid = (int)L; { const int q = nwg / NXCD, r = nwg % NXCD, xcd = wgid % NXCD, off = wgid / NXCD; wgid = (xcd < r ? xcd * (q + 1) : r * (q + 1) + (xcd - r) * q) + off; }
        const int nig = WGM * nN, gid = wgid / nig, fm = gid * WGM, gsz = (nM - fm) < WGM ? (nM - fm) : WGM;
        u.pm = fm + ((wgid % nig) % gsz); u.pn = (wgid % nig) / gsz; return true;
    }
};
struct EpiBf16 {
    static constexpr bool PERM = true;
    bf16_t* O; int ldc;
    __device__ __forceinline__ void operator()(const f32x4 (&acc)[2][2][4][2], const Unit& u, int wr, int wc, int fr_, int fq_) const {
        const int lane_ = opaque_tid() & 63, fr = lane_ & 15, fq = lane_ >> 4;
        const int row0 = u.pm * BM + wr * 64 + fr; const int col0 = u.pn * BM + wc * 32 + 8 * fq;
#pragma unroll
        for (int ai = 0; ai < 2; ++ai)
#pragma unroll
            for (int m = 0; m < 4; ++m) { bf16_t* rowp = O + (size_t)(row0 + ai * HALF + m * 16) * ldc + col0;
#pragma unroll
                for (int bj = 0; bj < 2; ++bj) { const f32x4 v0 = acc[ai][bj][m][0], v1 = acc[ai][bj][m][1];
                    u32x4 w; w.x = cvt_pk_bf16(v0[0], v0[1]); w.y = cvt_pk_bf16(v0[2], v0[3]); w.z = cvt_pk_bf16(v1[0], v1[1]); w.w = cvt_pk_bf16(v1[2], v1[3]);
                    *(u32x4*)(rowp + bj * HALF) = w; } }
    }
};
struct EpiGateRes {
    static constexpr bool PERM = false;
    const float* xp; const float* xs; float* out; const float* modbuf; int layer; int src_out;
    __device__ __forceinline__ void operator()(const f32x4 (&acc)[2][2][4][2], const Unit& u, int wr, int wc, int fr_, int fq_) const {
        const int lane_ = opaque_tid() & 63, fr = lane_ & 15, fq = lane_ >> 4;
        const int row0 = u.pm * BM + wr * 64 + fr, col0 = u.pn * BM + wc * 32 + 4 * fq;
        const int bi = batch_of_row(u.pm * BM);
        const float* g = modbuf + (size_t)(bi * 2 + layer) * 3072 + 2048;
#ifndef DIAG_LAM_S
#define DIAG_LAM_S 1.0f
#endif
#ifndef DIAG_LAM_P
#define DIAG_LAM_P 1.0f
#endif
        const float lam = (layer == 1) ? (bi >= 16 ? DIAG_LAM_S : DIAG_LAM_P) : 1.0f;
        f32x4 gv[2][2];
#pragma unroll
        for (int bj = 0; bj < 2; ++bj)
#pragma unroll
            for (int n = 0; n < 2; ++n) gv[bj][n] = *(const f32x4*)(g + col0 + bj * HALF + n * 16);
#pragma unroll
        for (int ai = 0; ai < 2; ++ai)
#pragma unroll
            for (int m = 0; m < 4; ++m) { const int row = row0 + ai * HALF + m * 16;
                const float* src = src_out ? out + (size_t)row * DM : (row < M_A ? xp + (size_t)row * DM : xs + (size_t)(row - M_A) * DM);
                float* dst = out + (size_t)row * DM;
#pragma unroll
                for (int bj = 0; bj < 2; ++bj)
#pragma unroll
                    for (int n = 0; n < 2; ++n) { const int c = col0 + bj * HALF + n * 16; const f32x4 xv = *(const f32x4*)(src + c);
                        *(f32x4*)(dst + c) = xv + gv[bj][n] * acc[ai][bj][m][n] * lam; } }
    }
};
struct EpiU1 {
    static constexpr bool PERM = false;
    bf16_t* U1; float* ssq_q; float* ssq_kv; bf16_t* kpe; const float2* rope;
    __device__ __forceinline__ void operator()(const f32x4 (&acc)[2][2][4][2], const Unit& u, int wr, int wc, int fr_, int fq_) const {
        const int lane_ = opaque_tid() & 63, fr = lane_ & 15, fq = lane_ >> 4;
        const int row0 = u.pm * BM + wr * 64 + fr, col0 = u.pn * BM + wc * 32 + 4 * fq;
#pragma unroll
        for (int ai = 0; ai < 2; ++ai)
#pragma unroll
            for (int m = 0; m < 4; ++m) { const int row = row0 + ai * HALF + m * 16; float sq[2] = {0.f, 0.f};
#pragma unroll
                for (int bj = 0; bj < 2; ++bj)
#pragma unroll
                    for (int n = 0; n < 2; ++n) { const f32x4 v = acc[ai][bj][m][n]; u32x2 w; w.x = cvt_pk_bf16(v[0], v[1]); w.y = cvt_pk_bf16(v[2], v[3]);
                        *(u32x2*)(U1 + (size_t)row * OD_INP + col0 + bj * HALF + n * 16) = w; sq[bj] += (v[0] * v[0] + v[1] * v[1]) + (v[2] * v[2] + v[3] * v[3]); }
                if (u.pn == 0) { float s = sq[0] + sq[1]; s += __shfl_xor(s, 16); s += __shfl_xor(s, 32); if (fq == 0) atomicAdd(ssq_q + row, s); }
                else if (u.pn == 1) { float s = sq[0]; s += __shfl_xor(s, 16); s += __shfl_xor(s, 32); if (fq == 0) atomicAdd(ssq_kv + row, s);
                    if (wc == 0) { const int pos = pos_of_row(row); const f32x4 a = acc[ai][1][m][0], b = acc[ai][1][m][1]; float o1[4], o2[4];
#pragma unroll
                        for (int e = 0; e < 4; ++e) { const float2 cs = rope[pos * 16 + 4 * fq + e]; o1[e] = a[e] * cs.x - b[e] * cs.y; o2[e] = b[e] * cs.x + a[e] * cs.y; }
                        u32x2 w1, w2; w1.x = cvt_pk_bf16(o1[0], o1[1]); w1.y = cvt_pk_bf16(o1[2], o1[3]); w2.x = cvt_pk_bf16(o2[0], o2[1]); w2.y = cvt_pk_bf16(o2[2], o2[3]);
                        *(u32x2*)(kpe + (size_t)row * 32 + 4 * fq) = w1; *(u32x2*)(kpe + (size_t)row * 32 + 16 + 4 * fq) = w2; } }
            }
    }
};
struct EpiQ {
    static constexpr bool PERM = false;
    bf16_t* Q; const float* ssq_q; const float2* rope; int row_off;
    __device__ __forceinline__ void operator()(const f32x4 (&acc)[2][2][4][2], const Unit& u, int wr, int wc, int fr_, int fq_) const {
        const int lane_ = opaque_tid() & 63, fr = lane_ & 15, fq = lane_ >> 4;
        const int row0 = u.pm * BM + wr * 64 + fr;
#pragma unroll
        for (int ai = 0; ai < 2; ++ai)
#pragma unroll
            for (int m = 0; m < 4; ++m) { const int rowg = row0 + ai * HALF + m * 16, grow = row_off + rowg;
                asm volatile("" ::: "memory"); const float rq = rsqrtf(ssq_q[grow] * (1.0f / 256.0f) + EPS) * QS96; const int pos = pos_of_row(grow);
#pragma unroll
                for (int bj = 0; bj < 2; ++bj) { const int cb = u.pn * BM + bj * HALF + wc * 32; const bool isrope = ((cb >> 5) % 3) == 2;
                    f32x4 v0 = acc[ai][bj][m][0] * rq, v1 = acc[ai][bj][m][1] * rq;
                    if (isrope) {
#pragma unroll
                        for (int e = 0; e < 4; ++e) { const float2 cs = rope[pos * 16 + 4 * fq + e]; const float a = v0[e], b = v1[e]; v0[e] = a * cs.x - b * cs.y; v1[e] = b * cs.x + a * cs.y; } }
                    u32x2 w0, w1; w0.x = cvt_pk_bf16(v0[0], v0[1]); w0.y = cvt_pk_bf16(v0[2], v0[3]); w1.x = cvt_pk_bf16(v1[0], v1[1]); w1.y = cvt_pk_bf16(v1[2], v1[3]);
                    *(u32x2*)(Q + (size_t)rowg * 1536 + cb + 4 * fq) = w0; *(u32x2*)(Q + (size_t)rowg * 1536 + cb + 16 + 4 * fq) = w1; } }
    }
};
struct EpiKV {
    static constexpr bool PERM = false;
    bf16_t* Kg; bf16_t* Vg; const float* ssq_kv; int row_off;
    __device__ __forceinline__ void operator()(const f32x4 (&acc)[2][2][4][2], const Unit& u, int wr, int wc, int fr_, int fq_) const {
        const int lane_ = opaque_tid() & 63, fr = lane_ & 15, fq = lane_ >> 4;
        const int row0 = u.pm * BM + wr * 64 + fr; bf16_t* dst = (wc < 2) ? Kg : Vg;
#pragma unroll
        for (int ai = 0; ai < 2; ++ai)
#pragma unroll
            for (int m = 0; m < 4; ++m) { const int rowg = row0 + ai * HALF + m * 16, grow = row_off + rowg;
                asm volatile("" ::: "memory"); const float rk = rsqrtf(ssq_kv[grow] * (1.0f / 128.0f) + EPS);
#pragma unroll
                for (int bj = 0; bj < 2; ++bj)
#pragma unroll
                    for (int n = 0; n < 2; ++n) { const int head = 2 * u.pn + bj; const int dcol = head * 64 + (wc & 1) * 32 + 16 * n + 4 * fq; const f32x4 v = acc[ai][bj][m][n] * rk;
                        u32x2 w; w.x = cvt_pk_bf16(v[0], v[1]); w.y = cvt_pk_bf16(v[2], v[3]); *(u32x2*)(dst + (size_t)rowg * 1024 + dcol) = w; } }
    }
};

template <class Epi, class Sched, bool ALIGN_EPI, bool SP2>
__device__ __forceinline__ void gemm_phase(LAS unsigned char* lds, const Gemm g, const Sched& S, const Epi& E) {
    const int tid = opaque_tid(), wid = __builtin_amdgcn_readfirstlane(tid >> 6), lane = tid & 63, wr = wid >> 2, wc = wid & 3, fr = lane & 15, fq = lane >> 4;
    const int K = g.K, nt = K / BK, lda = g.lda;
    unsigned voffA[2], voffB[2];
#pragma unroll
    for (int i = 0; i < 2; ++i) { int R, C; stage_rc(tid * 16 + i * 8192, R, C); const int Rb = Epi::PERM ? ((R & ~31) + perm32(R & 31)) : R;
        voffA[i] = (unsigned)(R * lda + C) * 2u; voffB[i] = (unsigned)(Rb * K + C) * 2u; }
    const size_t kstep = (size_t)(BK * 2);
    const size_t hstepA = (size_t)HALF * lda * 2, hstepB = (size_t)HALF * K * 2;
    const size_t tstepA = 2 * hstepA, tstepB = 2 * hstepB;
    const unsigned ldsw = (unsigned)wid * 1024u;
    const int aoff = lds_byte(wr * 64 + fr, fq * 8), boff = lds_byte(wc * 32 + fr, fq * 8);
#define PG8_SA(b, h) (((b) * 2 + (h)) * HTB)
#define PG8_SB(b, h) ((4 + (b) * 2 + (h)) * HTB)
#define PG8_STAGE(bufoff, gbase, voff) do { _Pragma("unroll") for (int _i = 0; _i < 2; ++_i) \
        __builtin_amdgcn_global_load_lds((const unsigned*)((const char*)(gbase) + (voff)[_i]), (LAS unsigned*)(lds + (bufoff) + ldsw + _i * 8192), 16, 0, 0); } while (0)
#define PG8_LDA(dst, b, h) do { _Pragma("unroll") for (int m = 0; m < 4; ++m) _Pragma("unroll") for (int k = 0; k < 2; ++k) dst[m][k] = *(const LAS bf16x8*)(lds + PG8_SA(b, h) + aoff + m * 2048 + k * 1024); } while (0)
#define PG8_LDB(dst, b, h) do { _Pragma("unroll") for (int n = 0; n < 2; ++n) _Pragma("unroll") for (int k = 0; k < 2; ++k) dst[n][k] = *(const LAS bf16x8*)(lds + PG8_SB(b, h) + boff + n * 2048 + k * 1024); } while (0)
#define PG8_MMA(ai, bj, At, Bt) do { __builtin_amdgcn_s_setprio(1); _Pragma("unroll") for (int m = 0; m < 4; ++m) _Pragma("unroll") for (int n = 0; n < 2; ++n) _Pragma("unroll") for (int k = 0; k < 2; ++k) \
        acc[ai][bj][m][n] = __builtin_amdgcn_mfma_f32_16x16x32_bf16(Bt[n][k], At[m][k], acc[ai][bj][m][n], 0, 0, 0); __builtin_amdgcn_s_setprio(0); } while (0)
#define PG8_WAIT_V(n) asm volatile("s_waitcnt vmcnt(" #n ")" ::: "memory")
#define PG8_WAIT_L(n) asm volatile("s_waitcnt lgkmcnt(" #n ")" ::: "memory")
#define PG8_BAR __builtin_amdgcn_s_barrier()
#define PG8_SCHED __builtin_amdgcn_sched_barrier(0)
    Unit cur, nxt; int ui = 0;
    if (!S.next(0, cur)) return;
    f32x4 acc[2][2][4][2];
#pragma unroll
    for (int a = 0; a < 2; ++a)
#pragma unroll
        for (int b = 0; b < 2; ++b)
#pragma unroll
            for (int m = 0; m < 4; ++m)
#pragma unroll
                for (int n = 0; n < 2; ++n) acc[a][b][m][n] = (f32x4){0.f, 0.f, 0.f, 0.f};
    bf16x8 At[4][2], B0[2][2], B1[2][2];
    const char* cA = (const char*)g.A + (size_t)cur.pm * tstepA; const char* cB = (const char*)g.Bt + (size_t)cur.pn * tstepB;
    if constexpr (SP2) {
        PG8_STAGE(PG8_SB(0, 0), cB, voffB); PG8_STAGE(PG8_SB(0, 1), cB + hstepB, voffB); PG8_STAGE(PG8_SA(0, 0), cA, voffA); PG8_STAGE(PG8_SA(0, 1), cA + hstepA, voffA);
        if (wr == 1) PG8_BAR;
        PG8_WAIT_V(2); PG8_BAR;
        PG8_STAGE(PG8_SB(1, 0), cB + kstep, voffB); PG8_STAGE(PG8_SA(1, 0), cA + kstep, voffA); PG8_STAGE(PG8_SB(1, 1), cB + hstepB + kstep, voffB);
        PG8_WAIT_V(6); PG8_BAR;
    }
    for (;;) {
        const bool has_next = S.next(ui + 1, nxt);
        const char* nA = has_next ? (const char*)g.A + (size_t)nxt.pm * tstepA : cA; const char* nB = has_next ? (const char*)g.Bt + (size_t)nxt.pn * tstepB : cB;
        for (int t = 0; t < nt; t += 2) {
            const bool last = (t == nt - 2);
            const char* a1 = cA + (size_t)(t + 1) * kstep;
            const char* a2 = last ? nA : cA + (size_t)(t + 2) * kstep; const char* b2 = last ? nB : cB + (size_t)(t + 2) * kstep;
            const char* a3 = a2 + kstep; const char* b3 = b2 + kstep;
            PG8_LDB(B0, 0, 0); PG8_LDB(B1, 0, 1); PG8_SCHED; PG8_LDA(At, 0, 0); PG8_STAGE(PG8_SA(1, 1), a1 + hstepA, voffA);
            PG8_WAIT_V(8); PG8_WAIT_L(0); PG8_BAR; PG8_MMA(0, 0, At, B0); PG8_MMA(0, 1, At, B1); PG8_BAR; PG8_SCHED;
            PG8_LDA(At, 0, 1); PG8_STAGE(PG8_SB(0, 0), b2, voffB); PG8_STAGE(PG8_SB(0, 1), b2 + hstepB, voffB); PG8_STAGE(PG8_SA(0, 0), a2, voffA);
            PG8_WAIT_V(8); PG8_WAIT_L(0); PG8_BAR; PG8_MMA(1, 0, At, B0); PG8_MMA(1, 1, At, B1); PG8_BAR; PG8_SCHED;
            PG8_LDB(B0, 1, 0); PG8_LDB(B1, 1, 1); PG8_SCHED; PG8_LDA(At, 1, 0); PG8_STAGE(PG8_SA(0, 1), a2 + hstepA, voffA);
            PG8_WAIT_V(8); PG8_WAIT_L(0); PG8_BAR; PG8_MMA(0, 0, At, B0); PG8_MMA(0, 1, At, B1); PG8_BAR; PG8_SCHED;
            PG8_LDA(At, 1, 1); PG8_STAGE(PG8_SB(1, 0), b3, voffB); PG8_STAGE(PG8_SB(1, 1), b3 + hstepB, voffB); PG8_STAGE(PG8_SA(1, 0), a3, voffA);
            PG8_WAIT_V(8); PG8_WAIT_L(0); PG8_BAR; PG8_MMA(1, 0, At, B0); PG8_MMA(1, 1, At, B1); PG8_BAR; PG8_SCHED;
        }
        if constexpr (ALIGN_EPI) { if (wr == 0) PG8_BAR; }
        E(acc, cur, wr, wc, fr, fq);
        if (!has_next) break;
#pragma unroll
        for (int a = 0; a < 2; ++a)
#pragma unroll
            for (int b = 0; b < 2; ++b)
#pragma unroll
                for (int m = 0; m < 4; ++m)
#pragma unroll
                    for (int n = 0; n < 2; ++n) acc[a][b][m][n] = (f32x4){0.f, 0.f, 0.f, 0.f};
        cur = nxt; cA = nA; cB = nB; ++ui;
        if constexpr (ALIGN_EPI) { if (wr == 1) PG8_BAR; }
    }
    PG8_WAIT_V(0);
    if constexpr (!ALIGN_EPI) { if (wr == 0) PG8_BAR; }
    PG8_BAR;
#undef PG8_SA
#undef PG8_SB
#undef PG8_STAGE
#undef PG8_LDA
#undef PG8_LDB
#undef PG8_MMA
#undef PG8_WAIT_V
#undef PG8_WAIT_L
#undef PG8_BAR
#undef PG8_SCHED
}
}

constexpr float THR2 = 11.0f;
constexpr int KSTR = 208;
constexpr int A_KBUF = 64 * KSTR, A_VBUF = 8192;
constexpr int A_K0 = 0, A_V0 = 2 * A_KBUF, A_WS = A_V0 + 2 * A_VBUF, A_TAB = A_WS + 2048;
__device__ __forceinline__ int crow(int r, int hi) { return (r & 3) + 8 * (r >> 2) + 4 * hi; }
__device__ __forceinline__ int v_st(int k, int c) { const int kk = (k & ~0xC) | ((k & 4) << 1) | ((k & 8) >> 1); return ((kk >> 3) * 2 + (c >> 5)) * 512 + ((kk & 7) * 32 + (c & 31)) * 2; }
__device__ __forceinline__ int v_rd_base(int lane) { return ((lane & 3) << 3) | (((lane >> 2) & 3) << 6) | (((lane >> 4) & 1) << 5) | (((lane >> 5) & 1) << 8); }
constexpr int v_rd_off(int d0, int ks, int half) { return d0 * 512 + ks * 2048 + half * 1024; }
template <int OFF> __device__ __forceinline__ s16x4 tr_read(int vb) {
    s16x4 r; asm volatile("ds_read_b64_tr_b16 %0, %1 offset:%2" : "=&v"(r) : "v"(vb), "i"(OFF) : "memory"); return r;
}
template <int D0> __device__ __forceinline__ void pv_one(f32x16& od, int vb, bf16x8 pa0, bf16x8 pa1, bf16x8 pa2, bf16x8 pa3) {
    const s16x4 l0 = tr_read<v_rd_off(D0, 0, 0)>(vb), h0 = tr_read<v_rd_off(D0, 0, 1)>(vb), l1 = tr_read<v_rd_off(D0, 1, 0)>(vb), h1 = tr_read<v_rd_off(D0, 1, 1)>(vb);
    const s16x4 l2 = tr_read<v_rd_off(D0, 2, 0)>(vb), h2 = tr_read<v_rd_off(D0, 2, 1)>(vb), l3 = tr_read<v_rd_off(D0, 3, 0)>(vb), h3 = tr_read<v_rd_off(D0, 3, 1)>(vb);
    asm volatile("s_waitcnt lgkmcnt(0)" ::: "memory"); __builtin_amdgcn_sched_barrier(0);
#define PK(L, H) (bf16x8){L[0], L[1], L[2], L[3], H[0], H[1], H[2], H[3]}
    od = __builtin_amdgcn_mfma_f32_32x32x16_bf16(pa0, PK(l0, h0), od, 0, 0, 0);
    od = __builtin_amdgcn_mfma_f32_32x32x16_bf16(pa1, PK(l1, h1), od, 0, 0, 0);
    od = __builtin_amdgcn_mfma_f32_32x32x16_bf16(pa2, PK(l2, h2), od, 0, 0, 0);
    od = __builtin_amdgcn_mfma_f32_32x32x16_bf16(pa3, PK(l3, h3), od, 0, 0, 0);
#undef PK
}

__device__ __forceinline__ void pv_both(f32x16& o0, f32x16& o1, int vb, bf16x8 pa0, bf16x8 pa1, bf16x8 pa2, bf16x8 pa3) {
    const s16x4 l0 = tr_read<v_rd_off(0, 0, 0)>(vb), h0 = tr_read<v_rd_off(0, 0, 1)>(vb), l1 = tr_read<v_rd_off(0, 1, 0)>(vb), h1 = tr_read<v_rd_off(0, 1, 1)>(vb);
    const s16x4 l2 = tr_read<v_rd_off(0, 2, 0)>(vb), h2 = tr_read<v_rd_off(0, 2, 1)>(vb), l3 = tr_read<v_rd_off(0, 3, 0)>(vb), h3 = tr_read<v_rd_off(0, 3, 1)>(vb);
    const s16x4 m0 = tr_read<v_rd_off(1, 0, 0)>(vb), n0 = tr_read<v_rd_off(1, 0, 1)>(vb), m1 = tr_read<v_rd_off(1, 1, 0)>(vb), n1 = tr_read<v_rd_off(1, 1, 1)>(vb);
    const s16x4 m2 = tr_read<v_rd_off(1, 2, 0)>(vb), n2 = tr_read<v_rd_off(1, 2, 1)>(vb), m3 = tr_read<v_rd_off(1, 3, 0)>(vb), n3 = tr_read<v_rd_off(1, 3, 1)>(vb);
    asm volatile("s_waitcnt lgkmcnt(8)" ::: "memory"); __builtin_amdgcn_sched_barrier(0);
#define PK(L, H) (bf16x8){L[0], L[1], L[2], L[3], H[0], H[1], H[2], H[3]}
    o0 = __builtin_amdgcn_mfma_f32_32x32x16_bf16(pa0, PK(l0, h0), o0, 0, 0, 0);
    o0 = __builtin_amdgcn_mfma_f32_32x32x16_bf16(pa1, PK(l1, h1), o0, 0, 0, 0);
    o0 = __builtin_amdgcn_mfma_f32_32x32x16_bf16(pa2, PK(l2, h2), o0, 0, 0, 0);
    o0 = __builtin_amdgcn_mfma_f32_32x32x16_bf16(pa3, PK(l3, h3), o0, 0, 0, 0);
    asm volatile("s_waitcnt lgkmcnt(0)" ::: "memory"); __builtin_amdgcn_sched_barrier(0);
    o1 = __builtin_amdgcn_mfma_f32_32x32x16_bf16(pa0, PK(m0, n0), o1, 0, 0, 0);
    o1 = __builtin_amdgcn_mfma_f32_32x32x16_bf16(pa1, PK(m1, n1), o1, 0, 0, 0);
    o1 = __builtin_amdgcn_mfma_f32_32x32x16_bf16(pa2, PK(m2, n2), o1, 0, 0, 0);
    o1 = __builtin_amdgcn_mfma_f32_32x32x16_bf16(pa3, PK(m3, n3), o1, 0, 0, 0);
#undef PK
}
__device__ __forceinline__ void mla_qkt_neg(f32x16& p0, f32x16& p1, const f32x16& negm, const unsigned char* Kb, const bf16x8* qr, int r32, int hi) {
#pragma unroll
    for (int d0 = 0; d0 < 6; ++d0) { const int cb = (d0 * 16 + hi * 8) * 2;
        const bf16x8 b0 = *(const bf16x8*)(Kb + r32 * KSTR + cb), b1 = *(const bf16x8*)(Kb + (32 + r32) * KSTR + cb);
        if (d0 == 0) { p0 = __builtin_amdgcn_mfma_f32_32x32x16_bf16(b0, qr[0], negm, 0, 0, 0); p1 = __builtin_amdgcn_mfma_f32_32x32x16_bf16(b1, qr[0], negm, 0, 0, 0); }
        else { p0 = __builtin_amdgcn_mfma_f32_32x32x16_bf16(b0, qr[d0], p0, 0, 0, 0); p1 = __builtin_amdgcn_mfma_f32_32x32x16_bf16(b1, qr[d0], p1, 0, 0, 0); } }
}
__device__ __forceinline__ void mla_softmax_rel(f32x16& p0, f32x16& p1, f32x16& negm, bool first, float& l_reg, float& alpha, bf16x8& pa0, bf16x8& pa1, bf16x8& pa2, bf16x8& pa3) {
    float pmax = p0[0];
#pragma unroll
    for (int r = 1; r < 16; ++r) pmax = fmaxf(pmax, p0[r]);
#pragma unroll
    for (int r = 0; r < 16; ++r) pmax = fmaxf(pmax, p1[r]);
    { auto rr = __builtin_amdgcn_permlane32_swap(__float_as_uint(pmax), __float_as_uint(pmax), false, false); pmax = fmaxf(__uint_as_float(rr[0]), __uint_as_float(rr[1])); }
    alpha = 1.f;
    if (__builtin_expect(first || !__all(pmax <= THR2), 0)) {
        const float d = first ? pmax : fmaxf(pmax, 0.f);
        if (!first) alpha = __builtin_amdgcn_exp2f(-d);
        const float nm = negm[0] - d;
#pragma unroll
        for (int r = 0; r < 16; ++r) { negm[r] = nm; p0[r] -= d; p1[r] -= d; }
    }
#pragma unroll
    for (int r = 0; r < 16; ++r) { p0[r] = __builtin_amdgcn_exp2f(p0[r]); p1[r] = __builtin_amdgcn_exp2f(p1[r]); }
    float ps = 0.f;
#pragma unroll
    for (int r = 0; r < 16; ++r) ps += p0[r];
#pragma unroll
    for (int r = 0; r < 16; ++r) ps += p1[r];
    { auto rr = __builtin_amdgcn_permlane32_swap(__float_as_uint(ps), __float_as_uint(ps), false, false); ps = __uint_as_float(rr[0]) + __uint_as_float(rr[1]); }
    l_reg = l_reg * alpha + ps;
#define PK4(Pv, BASE, OUT) do { unsigned a0 = cvt_pk_bf16(Pv[BASE + 0], Pv[BASE + 1]), a1 = cvt_pk_bf16(Pv[BASE + 2], Pv[BASE + 3]);   \
    unsigned b0_ = cvt_pk_bf16(Pv[BASE + 4], Pv[BASE + 5]), b1_ = cvt_pk_bf16(Pv[BASE + 6], Pv[BASE + 7]);                              \
    auto r0 = __builtin_amdgcn_permlane32_swap(a0, b0_, false, false); auto r1 = __builtin_amdgcn_permlane32_swap(a1, b1_, false, false); \
    u32x4 w = {r0[0], r1[0], r0[1], r1[1]}; OUT = *reinterpret_cast<bf16x8*>(&w); } while (0)
    PK4(p0, 0, pa0); PK4(p0, 8, pa1); PK4(p1, 0, pa2); PK4(p1, 8, pa3);
#undef PK4
}
__device__ __forceinline__ void mla_softmax_rel_kp(f32x16& p0, f32x16& p1, f32x16& negm, bool first, float& l_reg, float& alpha, bf16x8& pa0, bf16x8& pa1, bf16x8& pa2, bf16x8& pa3) {
    float pmax = p0[0];
#pragma unroll
    for (int r = 1; r < 16; ++r) pmax = fmaxf(pmax, p0[r]);
#pragma unroll
    for (int r = 0; r < 16; ++r) pmax = fmaxf(pmax, p1[r]);
    { auto rr = __builtin_amdgcn_permlane32_swap(__float_as_uint(pmax), __float_as_uint(pmax), false, false); pmax = fmaxf(__uint_as_float(rr[0]), __uint_as_float(rr[1])); }
    alpha = 1.f;
    if (__builtin_expect(first || !__all(pmax <= THR2), 0)) {
        const float d = first ? pmax : fmaxf(pmax, 0.f);
        if (!first) alpha = __builtin_amdgcn_exp2f(-d);
        const float nm = negm[0] - d;
#pragma unroll
        for (int r = 0; r < 16; ++r) { negm[r] = nm; p0[r] -= d; p1[r] -= d; }
    }
#pragma unroll
    for (int r = 0; r < 16; ++r) { p0[r] = __builtin_amdgcn_exp2f(p0[r]); p1[r] = __builtin_amdgcn_exp2f(p1[r]); }
    float ps = 0.f;
#pragma unroll
    for (int r = 0; r < 16; ++r) ps += p0[r];
#pragma unroll
    for (int r = 0; r < 16; ++r) ps += p1[r];
    { auto rr = __builtin_amdgcn_permlane32_swap(__float_as_uint(ps), __float_as_uint(ps), false, false); ps = __uint_as_float(rr[0]) + __uint_as_float(rr[1]); }
    l_reg = l_reg * alpha + ps;
    pa0 = pack8(p0, 0); pa1 = pack8(p0, 8); pa2 = pack8(p1, 0); pa3 = pack8(p1, 8);
}
template <int MODE>
__device__ __forceinline__ void attn_unit(const Params& P, unsigned char* lds, int h, int rb, int grp, bool dry = false) {
    constexpr int ND = (MODE == 2) ? 6 : 4;
    const int tid = opaque_tid(), lane = tid & 63, r32 = lane & 31, hi = lane >> 5; const int wid = __builtin_amdgcn_readfirstlane(tid >> 6);
    unsigned char* ws = P.ws;
    int l, seq0, t0; size_t rowoff = 0;
    const bf16_t *Qp, *Kp, *Vp, *Kpe = nullptr; bf16_t* Gp; int ldq, ldk, ldg;
    if (MODE == 2) {
        l = grp ? 16384 : 2048; rowoff = grp ? M_A : 0; const int m0 = rb * 256; seq0 = m0 & ~(l - 1); t0 = m0 - seq0;
        Qp = (const bf16_t*)(ws + WS_QG) + h * 96; ldq = 1536; Kp = (const bf16_t*)(ws + WS_KG) + h * 64; Vp = (const bf16_t*)(ws + WS_VG) + h * 64; ldk = 1024;
        Kpe = (const bf16_t*)(ws + WS_KPE) + rowoff * 32; Gp = (bf16_t*)(ws + WS_U1) + rowoff * OD_INP + 416 + h * 64; ldg = OD_INP;
    } else {
        const int m0 = rb * 256;
        if (m0 < M_A) { l = 2048; seq0 = m0 & ~2047; } else { l = 16384; seq0 = M_A + ((m0 - M_A) & ~16383); }
        t0 = m0 - seq0; const bf16_t* U0 = (const bf16_t*)(ws + WS_U0); ldq = ldk = ldg = EV_IN;
        if (MODE == 0) { Qp = U0 + h * 64; Kp = U0 + 512 + h * 64; Vp = U0 + 1024 + h * 64; Gp = (bf16_t*)(ws + WS_U0) + 2304 + h * 64; }
        else { Qp = U0 + 1536 + h * 64; Kp = U0 + 2048 + (h >> 2) * 64; Vp = U0 + 2176 + (h >> 2) * 64; Gp = (bf16_t*)(ws + WS_U0) + 2304 + 512 + h * 64; }
    }
    int NT, key0;
    int na_r = 0, na_rs = 0, na_tlo = 0, na_cq = 0, na_cs = 0;
    if (MODE == 0) { const int rows = l >> 6, R4 = t0 >> 6;
        auto rsf = [&](int r) { int s = r - 4; s = s < 0 ? 0 : s; return s > rows - 8 ? rows - 8 : s; };
        na_tlo = rsf(R4); NT = rsf(R4 + 3) + 8 - na_tlo; key0 = na_tlo * 64;
        na_r = R4 + (wid >> 1); na_rs = rsf(na_r); na_cq = (wid & 1) * 32 + r32; na_cs = na_cq - 8; na_cs = na_cs < 0 ? 0 : (na_cs > 48 ? 48 : na_cs);
    } else if (MODE == 1) { const int jlo = (t0 == 0) ? 2 : 0; int jhi = (l - t0 + 128) >> 6; jhi = jhi > 8 ? 8 : jhi; NT = jhi - jlo; key0 = t0 - 128 + 64 * jlo;
    } else { NT = l >> 6; key0 = 0; }
    float* tab = (float*)(lds + A_TAB);
    if (MODE == 0) {
        const float* rpb = P.na_rpb + (size_t)h * 15 * 31;
        for (int i = tid; i < 15 * 128; i += 512) { const int dr = i >> 7, dc = (i & 127) - 63; tab[i] = (dc >= -15 && dc <= 15) ? rpb[dr * 31 + dc + 15] * LOG2E : 0.f; }
    } else if (MODE == 1) {
        for (int i = tid; i < 1024; i += 512) { const int rel = i - 512; tab[i] = (rel >= -128 && rel <= 128) ? P.t5_bias[(int)T5_BUCKET[rel + 128] * 8 + h] * LOG2E : 0.f; }
    }
    bf16x8 qr[ND];
    { const bf16_t* Qw = Qp + (size_t)(seq0 + t0 + wid * 32 + r32) * ldq + hi * 8;
#pragma unroll
      for (int d0 = 0; d0 < ND; ++d0) qr[d0] = *(const bf16x8*)(Qw + d0 * 16); }
    float* wsf = (float*)(lds + A_WS) + wid * 64; float* li_l = wsf; float* al_l = wsf + 32;
    float m_reg = -1e30f, l_reg = 0.f; f32x16 o[2] = {};
    if (dry) Gp = (bf16_t*)(ws + WS_END) + h * 64 - (size_t)(seq0 + t0) * ldg + (size_t)((rb & 7) * 256) * ldg;
    bf16_t* Gw = Gp + (size_t)(seq0 + t0 + wid * 32) * ldg + r32;
    bf16_t gq[32];
#pragma unroll
    for (int r = 0; r < 16; ++r) { const int orow = crow(r, hi); gq[2 * r] = Gw[(size_t)orow * ldg]; gq[2 * r + 1] = Gw[(size_t)orow * ldg + 32]; }
    const int sr = tid >> 3, sc = (tid & 7) * 8, pr = tid >> 2, pc = (tid & 3) * 8;
    const int vst = v_st(sr, sc);
    const int vb0 = (int)(uintptr_t)(lds + A_V0) + v_rd_base(lane);
    bf16x8 kst, vstg, pst;
#define SLOAD(j) do { const size_t krow = (size_t)(seq0 + key0 + 64 * (j) + sr); kst = *(const bf16x8*)(Kp + krow * ldk + sc); vstg = *(const bf16x8*)(Vp + krow * ldk + sc); \
        if (MODE == 2) { if (tid < 256) pst = *(const bf16x8*)(Kpe + (size_t)(seq0 + key0 + 64 * (j) + pr) * 32 + pc); } } while (0)
#define SWRITE(b) do { *(bf16x8*)(lds + A_K0 + (b) * A_KBUF + sr * KSTR + sc * 2) = kst; *(bf16x8*)(lds + A_V0 + (b) * A_VBUF + vst) = vstg; \
        if (MODE == 2) { if (tid < 256) *(bf16x8*)(lds + A_K0 + (b) * A_KBUF + pr * KSTR + 128 + pc * 2) = pst; } } while (0)
    SLOAD(0); SWRITE(0); __syncthreads();
    for (int j = 0; j < NT; ++j) {
        const int buf = j & 1;
        if (j + 1 < NT) SLOAD(j + 1);
        bool active = true;
        if (MODE == 0) { const int kr = na_tlo + j; active = (kr >= na_rs) && (kr < na_rs + 8); }
        if (MODE == 1) { const int jj = (key0 - t0 + 128) / 64 + j; active = (64 * jj + 63 >= 32 * wid) && (64 * jj <= 32 * wid + 287); }
        if (active) {
            f32x16 p0 = {}, p1 = {};
            const unsigned char* Kb = lds + A_K0 + buf * A_KBUF;
#pragma unroll
            for (int d0 = 0; d0 < ND; ++d0) { const int cb = (d0 * 16 + hi * 8) * 2;
                const bf16x8 b0 = *(const bf16x8*)(Kb + r32 * KSTR + cb), b1 = *(const bf16x8*)(Kb + (32 + r32) * KSTR + cb);
                p0 = __builtin_amdgcn_mfma_f32_32x32x16_bf16(b0, qr[d0], p0, 0, 0, 0);
                p1 = __builtin_amdgcn_mfma_f32_32x32x16_bf16(b1, qr[d0], p1, 0, 0, 0); }
            if (MODE == 0) { const int dr = na_tlo + j - na_r; const float* tb = tab + (dr + 7) * 128 + (4 * hi - na_cq + 63); const int v = 4 * hi - na_cs;
#pragma unroll
                for (int r = 0; r < 16; ++r) { const int c0 = (r & 3) + 8 * (r >> 2);
                    p0[r] = ((unsigned)(c0 + v) < 16u) ? p0[r] + tb[c0] : -1e30f;
                    p1[r] = ((unsigned)(c0 + 32 + v) < 16u) ? p1[r] + tb[c0 + 32] : -1e30f; } }
            if (MODE == 1) { const int base = key0 + 64 * j - t0 + 4 * hi - 32 * wid - r32; const float* tb = tab + 512 + base;
#pragma unroll
                for (int r = 0; r < 16; ++r) { const int c0 = (r & 3) + 8 * (r >> 2);
                    p0[r] = ((unsigned)(base + c0 + 128) <= 256u) ? p0[r] + tb[c0] : -1e30f;
                    p1[r] = ((unsigned)(base + c0 + 32 + 128) <= 256u) ? p1[r] + tb[c0 + 32] : -1e30f; } }
            float pmax = p0[0];
#pragma unroll
            for (int r = 1; r < 16; ++r) pmax = fmaxf(pmax, p0[r]);
#pragma unroll
            for (int r = 0; r < 16; ++r) pmax = fmaxf(pmax, p1[r]);
            { auto rr = __builtin_amdgcn_permlane32_swap(__float_as_uint(pmax), __float_as_uint(pmax), false, false); pmax = fmaxf(__uint_as_float(rr[0]), __uint_as_float(rr[1])); }
            const float mn = fmaxf(m_reg, pmax); const float alpha = __builtin_amdgcn_exp2f(m_reg - mn); m_reg = mn;
#pragma unroll
            for (int r = 0; r < 16; ++r) { p0[r] = __builtin_amdgcn_exp2f(p0[r] - mn); p1[r] = __builtin_amdgcn_exp2f(p1[r] - mn); }
            float ps = 0.f;
#pragma unroll
            for (int r = 0; r < 16; ++r) ps += p0[r] + p1[r];
            { auto rr = __builtin_amdgcn_permlane32_swap(__float_as_uint(ps), __float_as_uint(ps), false, false); ps = __uint_as_float(rr[0]) + __uint_as_float(rr[1]); }
            l_reg = l_reg * alpha + ps;
            if (__any(alpha < 1.f)) { if (hi == 0) al_l[r32] = alpha; LDS_WAIT();
#pragma unroll
                for (int d = 0; d < 2; ++d)
#pragma unroll
                    for (int r = 0; r < 16; ++r) o[d][r] *= al_l[crow(r, hi)];
                LDS_WAIT(); }
            bf16x8 pa0, pa1, pa2, pa3;
#define PK4(Pv, BASE, OUT) do { unsigned a0 = cvt_pk_bf16(Pv[BASE + 0], Pv[BASE + 1]), a1 = cvt_pk_bf16(Pv[BASE + 2], Pv[BASE + 3]);   \
    unsigned b0_ = cvt_pk_bf16(Pv[BASE + 4], Pv[BASE + 5]), b1_ = cvt_pk_bf16(Pv[BASE + 6], Pv[BASE + 7]);                              \
    auto r0 = __builtin_amdgcn_permlane32_swap(a0, b0_, false, false); auto r1 = __builtin_amdgcn_permlane32_swap(a1, b1_, false, false); \
    u32x4 w = {r0[0], r1[0], r0[1], r1[1]}; OUT = *reinterpret_cast<bf16x8*>(&w); } while (0)
            PK4(p0, 0, pa0); PK4(p0, 8, pa1); PK4(p1, 0, pa2); PK4(p1, 8, pa3);
#undef PK4
            const int vb = vb0 + buf * A_VBUF;
            pv_both(o[0], o[1], vb, pa0, pa1, pa2, pa3);
        }
        if (j + 1 < NT) SWRITE((j + 1) & 1);
        __syncthreads();
    }
#undef SLOAD
#undef SWRITE
    if (MODE == 1) l_reg += __builtin_amdgcn_exp2f(P.wb_sink[h] * LOG2E - m_reg);
    if (hi == 0) li_l[r32] = l_reg; LDS_WAIT();
    float rli[16];
#pragma unroll
    for (int r = 0; r < 16; ++r) rli[r] = __builtin_amdgcn_rcpf(li_l[crow(r, hi)]);
#pragma unroll
    for (int r = 0; r < 16; ++r) { const int orow = crow(r, hi);
#pragma unroll
        for (int d0 = 0; d0 < 2; ++d0) { bf16_t* gp = Gw + (size_t)orow * ldg + d0 * 32; const float g = bf2f(gq[2 * r + d0]);
            const float sg = g * __builtin_amdgcn_rcpf(1.f + __builtin_amdgcn_exp2f(-g * LOG2E));
            *gp = (bf16_t)(cvt_pk_bf16(o[d0][r] * rli[r] * sg, 0.f) & 0xffffu); } }
    LDS_WAIT();
}

__device__ __forceinline__ void mla_partialSM(f32x16& p0, f32x16& p1, float& m_reg, float& alpha) {
    float pmax = p0[0];
#pragma unroll
    for (int r = 1; r < 16; ++r) pmax = fmaxf(pmax, p0[r]);
#pragma unroll
    for (int r = 0; r < 16; ++r) pmax = fmaxf(pmax, p1[r]);
    { auto rr = __builtin_amdgcn_permlane32_swap(__float_as_uint(pmax), __float_as_uint(pmax), false, false); pmax = fmaxf(__uint_as_float(rr[0]), __uint_as_float(rr[1])); }
    float mn;
    if (__builtin_expect(__all(pmax - m_reg <= THR2), 1)) { mn = m_reg; alpha = 1.f; }
    else { mn = fmaxf(m_reg, pmax); alpha = __builtin_amdgcn_exp2f(m_reg - mn); m_reg = mn; }
#pragma unroll
    for (int r = 0; r < 16; ++r) { p0[r] -= mn; p1[r] -= mn; }
#pragma unroll
    for (int r = 0; r < 16; ++r) p0[r] = __builtin_amdgcn_exp2f(p0[r]);
}
__device__ __forceinline__ void mla_finishSM(f32x16& p0, f32x16& p1, float alpha, float& l_reg, bf16x8& pa0, bf16x8& pa1, bf16x8& pa2, bf16x8& pa3) {
#pragma unroll
    for (int r = 0; r < 16; ++r) p1[r] = __builtin_amdgcn_exp2f(p1[r]);
    float ps = 0.f;
#pragma unroll
    for (int r = 0; r < 16; ++r) ps += p0[r];
#pragma unroll
    for (int r = 0; r < 16; ++r) ps += p1[r];
    { auto rr = __builtin_amdgcn_permlane32_swap(__float_as_uint(ps), __float_as_uint(ps), false, false); ps = __uint_as_float(rr[0]) + __uint_as_float(rr[1]); }
    l_reg = l_reg * alpha + ps;
#define PK4(Pv, BASE, OUT) do { unsigned a0 = cvt_pk_bf16(Pv[BASE + 0], Pv[BASE + 1]), a1 = cvt_pk_bf16(Pv[BASE + 2], Pv[BASE + 3]);   \
    unsigned b0_ = cvt_pk_bf16(Pv[BASE + 4], Pv[BASE + 5]), b1_ = cvt_pk_bf16(Pv[BASE + 6], Pv[BASE + 7]);                              \
    auto r0 = __builtin_amdgcn_permlane32_swap(a0, b0_, false, false); auto r1 = __builtin_amdgcn_permlane32_swap(a1, b1_, false, false); \
    u32x4 w = {r0[0], r1[0], r0[1], r1[1]}; OUT = *reinterpret_cast<bf16x8*>(&w); } while (0)
    PK4(p0, 0, pa0); PK4(p0, 8, pa1); PK4(p1, 0, pa2); PK4(p1, 8, pa3);
#undef PK4
}
__device__ __forceinline__ void mla_qkt(f32x16& p0, f32x16& p1, const unsigned char* Kb, const bf16x8* qr, int r32, int hi) {
    p0 = f32x16{}; p1 = f32x16{};
#pragma unroll
    for (int d0 = 0; d0 < 6; ++d0) { const int cb = (d0 * 16 + hi * 8) * 2;
        const bf16x8 b0 = *(const bf16x8*)(Kb + r32 * KSTR + cb), b1 = *(const bf16x8*)(Kb + (32 + r32) * KSTR + cb);
        p0 = __builtin_amdgcn_mfma_f32_32x32x16_bf16(b0, qr[d0], p0, 0, 0, 0);
        p1 = __builtin_amdgcn_mfma_f32_32x32x16_bf16(b1, qr[d0], p1, 0, 0, 0); }
}
__device__ __forceinline__ void mla_unit(const Params& P, unsigned char* lds, int h, int rb, int grp, bool dry = false) {
    const int tid = opaque_tid(), lane = tid & 63, r32 = lane & 31, hi = lane >> 5; const int wid = __builtin_amdgcn_readfirstlane(tid >> 6);
    unsigned char* ws = P.ws;
    const int l = grp ? 16384 : 2048; const size_t rowoff = grp ? M_A : 0; const int m0 = rb * 256; const int seq0 = m0 & ~(l - 1), t0 = m0 - seq0;
    const bf16_t* Qp = (const bf16_t*)(ws + WS_QG) + h * 96; const bf16_t* Kp = (const bf16_t*)(ws + WS_KG) + h * 64; const bf16_t* Vp = (const bf16_t*)(ws + WS_VG) + h * 64;
    const bf16_t* Kpe = (const bf16_t*)(ws + WS_KPE) + rowoff * 32; bf16_t* Gp = (bf16_t*)(ws + WS_U1) + rowoff * OD_INP + 416 + h * 64; const int ldg = OD_INP;
    const int NT = l >> 6;
    bf16x8 qr[6];
    { const bf16_t* Qw = Qp + (size_t)(seq0 + t0 + wid * 32 + r32) * 1536 + hi * 8;
#pragma unroll
      for (int d0 = 0; d0 < 6; ++d0) qr[d0] = *(const bf16x8*)(Qw + d0 * 16); }
    float* wsf = (float*)(lds + A_WS) + wid * 64; float* li_l = wsf; float* al_l = wsf + 32;
    float m_reg = -1e30f, l_reg = 0.f; f32x16 o[2] = {};
    const int sr = tid >> 3, sc = (tid & 7) * 8, pr = (tid & 255) >> 2, pc = (tid & 3) * 8;
    const int vst = v_st(sr, sc);
    const int vb0 = (int)(uintptr_t)(lds + A_V0) + v_rd_base(lane);
    bf16x8 ksE, vsE, psE, ksO, vsO, psO;
#define SLOAD(S, j) do { const size_t krow = (size_t)(seq0 + 64 * (j) + sr); ks##S = *(const bf16x8*)(Kp + krow * 1024 + sc); vs##S = *(const bf16x8*)(Vp + krow * 1024 + sc); \
        ps##S = *(const bf16x8*)(Kpe + (size_t)(seq0 + 64 * (j) + pr) * 32 + pc); } while (0)
#define SWRITE(b, S) do { *(bf16x8*)(lds + A_K0 + (b) * A_KBUF + sr * KSTR + sc * 2) = ks##S; *(bf16x8*)(lds + A_V0 + (b) * A_VBUF + vst) = vs##S; \
        if (tid < 256) *(bf16x8*)(lds + A_K0 + (b) * A_KBUF + pr * KSTR + 128 + pc * 2) = ps##S; } while (0)
#define RESC(a) do { if (__any((a) < 1.f)) { if (hi == 0) al_l[r32] = (a); LDS_WAIT(); \
        _Pragma("unroll") for (int d = 0; d < 2; ++d) _Pragma("unroll") for (int r = 0; r < 16; ++r) o[d][r] *= al_l[crow(r, hi)]; LDS_WAIT(); } } while (0)
#define SBAR() __builtin_amdgcn_sched_barrier(0)
    const unsigned char* K0 = lds + A_K0; const unsigned char* K1 = lds + A_K0 + A_KBUF;
    f32x16 pA0, pA1, pB0, pB1; float alA, alB; bf16x8 pa0, pa1, pa2, pa3;
    SLOAD(E, 0); SWRITE(0, E); __syncthreads();
    mla_qkt(pA0, pA1, K0, qr, r32, hi); mla_partialSM(pA0, pA1, m_reg, alA);
    SLOAD(O, 1); SLOAD(E, 2); SWRITE(1, O); __syncthreads();
    for (int j = 1; j + 1 < NT; j += 2) {
        SBAR(); mla_qkt(pB0, pB1, K1, qr, r32, hi);
        mla_finishSM(pA0, pA1, alA, l_reg, pa0, pa1, pa2, pa3); SBAR();
        SLOAD(O, j + 2); SBAR();
        pv_one<0>(o[0], vb0, pa0, pa1, pa2, pa3); pv_one<1>(o[1], vb0, pa0, pa1, pa2, pa3); mla_partialSM(pB0, pB1, m_reg, alB);
        __syncthreads(); SWRITE(0, E);
        RESC(alB); __syncthreads();
        SBAR(); mla_qkt(pA0, pA1, K0, qr, r32, hi);
        mla_finishSM(pB0, pB1, alB, l_reg, pa0, pa1, pa2, pa3); SBAR();
        if (j + 3 < NT) SLOAD(E, j + 3); SBAR();
        pv_one<0>(o[0], vb0 + A_VBUF, pa0, pa1, pa2, pa3); pv_one<1>(o[1], vb0 + A_VBUF, pa0, pa1, pa2, pa3); mla_partialSM(pA0, pA1, m_reg, alA);
        __syncthreads(); SWRITE(1, O);
        RESC(alA); __syncthreads();
    }
    SBAR(); mla_qkt(pB0, pB1, K1, qr, r32, hi);
    mla_finishSM(pA0, pA1, alA, l_reg, pa0, pa1, pa2, pa3); SBAR();
    pv_one<0>(o[0], vb0, pa0, pa1, pa2, pa3); pv_one<1>(o[1], vb0, pa0, pa1, pa2, pa3); mla_partialSM(pB0, pB1, m_reg, alB);
    RESC(alB);
    mla_finishSM(pB0, pB1, alB, l_reg, pa0, pa1, pa2, pa3); SBAR();
    pv_one<0>(o[0], vb0 + A_VBUF, pa0, pa1, pa2, pa3); pv_one<1>(o[1], vb0 + A_VBUF, pa0, pa1, pa2, pa3);
#undef SLOAD
#undef SWRITE
#undef RESC
#undef SBAR
    if (hi == 0) li_l[r32] = l_reg; LDS_WAIT();
    float rli[16];
#pragma unroll
    for (int r = 0; r < 16; ++r) rli[r] = __builtin_amdgcn_rcpf(li_l[crow(r, hi)]);
    if (dry) Gp = (bf16_t*)(ws + WS_END) + h * 64 - (size_t)(seq0 + t0) * ldg + (size_t)((rb & 7) * 256) * ldg;
    bf16_t* Gw = Gp + (size_t)(seq0 + t0 + wid * 32) * ldg + r32;
#pragma unroll
    for (int r = 0; r < 16; ++r) { const int orow = crow(r, hi);
#pragma unroll
        for (int d0 = 0; d0 < 2; ++d0) { bf16_t* gp = Gw + (size_t)orow * ldg + d0 * 32; const float g = bf2f(*gp);
            const float sg = g * __builtin_amdgcn_rcpf(1.f + __builtin_amdgcn_exp2f(-g * LOG2E));
            *gp = (bf16_t)(cvt_pk_bf16(o[d0][r] * rli[r] * sg, 0.f) & 0xffffu); } }
    LDS_WAIT();
    __syncthreads();
}

__device__ __forceinline__ int v_rd_base_kp(int lane) { return ((lane & 3) << 3) | (((lane >> 2) & 3) << 6) | (((lane >> 4) & 1) << 5) | (((lane >> 5) & 1) << 10); }
constexpr int v_rd_off_kp(int d0, int ks, int rows47) { return d0 * 512 + ks * 2048 + rows47 * 256; }
__device__ __forceinline__ void pv_both_kp(f32x16& o0, f32x16& o1, int vb, bf16x8 pa0, bf16x8 pa1, bf16x8 pa2, bf16x8 pa3) {
    const s16x4 l0 = tr_read<v_rd_off_kp(0, 0, 0)>(vb), h0 = tr_read<v_rd_off_kp(0, 0, 1)>(vb), l1 = tr_read<v_rd_off_kp(0, 1, 0)>(vb), h1 = tr_read<v_rd_off_kp(0, 1, 1)>(vb);
    const s16x4 l2 = tr_read<v_rd_off_kp(0, 2, 0)>(vb), h2 = tr_read<v_rd_off_kp(0, 2, 1)>(vb), l3 = tr_read<v_rd_off_kp(0, 3, 0)>(vb), h3 = tr_read<v_rd_off_kp(0, 3, 1)>(vb);
    const s16x4 m0 = tr_read<v_rd_off_kp(1, 0, 0)>(vb), n0 = tr_read<v_rd_off_kp(1, 0, 1)>(vb), m1 = tr_read<v_rd_off_kp(1, 1, 0)>(vb), n1 = tr_read<v_rd_off_kp(1, 1, 1)>(vb);
    const s16x4 m2 = tr_read<v_rd_off_kp(1, 2, 0)>(vb), n2 = tr_read<v_rd_off_kp(1, 2, 1)>(vb), m3 = tr_read<v_rd_off_kp(1, 3, 0)>(vb), n3 = tr_read<v_rd_off_kp(1, 3, 1)>(vb);
    asm volatile("s_waitcnt lgkmcnt(8)" ::: "memory"); __builtin_amdgcn_sched_barrier(0);
#define PK(L, H) (bf16x8){L[0], L[1], L[2], L[3], H[0], H[1], H[2], H[3]}
    o0 = __builtin_amdgcn_mfma_f32_32x32x16_bf16(pa0, PK(l0, h0), o0, 0, 0, 0);
    o0 = __builtin_amdgcn_mfma_f32_32x32x16_bf16(pa1, PK(l1, h1), o0, 0, 0, 0);
    o0 = __builtin_amdgcn_mfma_f32_32x32x16_bf16(pa2, PK(l2, h2), o0, 0, 0, 0);
    o0 = __builtin_amdgcn_mfma_f32_32x32x16_bf16(pa3, PK(l3, h3), o0, 0, 0, 0);
    asm volatile("s_waitcnt lgkmcnt(0)" ::: "memory"); __builtin_amdgcn_sched_barrier(0);
    o1 = __builtin_amdgcn_mfma_f32_32x32x16_bf16(pa0, PK(m0, n0), o1, 0, 0, 0);
    o1 = __builtin_amdgcn_mfma_f32_32x32x16_bf16(pa1, PK(m1, n1), o1, 0, 0, 0);
    o1 = __builtin_amdgcn_mfma_f32_32x32x16_bf16(pa2, PK(m2, n2), o1, 0, 0, 0);
    o1 = __builtin_amdgcn_mfma_f32_32x32x16_bf16(pa3, PK(m3, n3), o1, 0, 0, 0);
#undef PK
}
__device__ __forceinline__ void mla_softmax_seg(f32x16& p0, f32x16& p1, float& m_reg, float& l_reg, float& alpha, bf16x8& pa0, bf16x8& pa1, bf16x8& pa2, bf16x8& pa3) {
    float pmax = p0[0];
#pragma unroll
    for (int r = 1; r < 16; ++r) pmax = fmaxf(pmax, p0[r]);
#pragma unroll
    for (int r = 0; r < 16; ++r) pmax = fmaxf(pmax, p1[r]);
    { auto rr = __builtin_amdgcn_permlane32_swap(__float_as_uint(pmax), __float_as_uint(pmax), false, false); pmax = fmaxf(__uint_as_float(rr[0]), __uint_as_float(rr[1])); }
    float mn;
    if (__builtin_expect(__all(pmax - m_reg <= THR2), 1)) { mn = m_reg; alpha = 1.f; }
    else { mn = fmaxf(m_reg, pmax); alpha = __builtin_amdgcn_exp2f(m_reg - mn); m_reg = mn; }
#pragma unroll
    for (int r = 0; r < 16; ++r) { p0[r] = __builtin_amdgcn_exp2f(p0[r] - mn); p1[r] = __builtin_amdgcn_exp2f(p1[r] - mn); }
    float ps = 0.f;
#pragma unroll
    for (int r = 0; r < 16; ++r) ps += p0[r];
#pragma unroll
    for (int r = 0; r < 16; ++r) ps += p1[r];
    { auto rr = __builtin_amdgcn_permlane32_swap(__float_as_uint(ps), __float_as_uint(ps), false, false); ps = __uint_as_float(rr[0]) + __uint_as_float(rr[1]); }
    l_reg = l_reg * alpha + ps;
#define PK4(Pv, BASE, OUT) do { unsigned a0 = cvt_pk_bf16(Pv[BASE + 0], Pv[BASE + 1]), a1 = cvt_pk_bf16(Pv[BASE + 2], Pv[BASE + 3]);   \
    unsigned b0_ = cvt_pk_bf16(Pv[BASE + 4], Pv[BASE + 5]), b1_ = cvt_pk_bf16(Pv[BASE + 6], Pv[BASE + 7]);                              \
    auto r0 = __builtin_amdgcn_permlane32_swap(a0, b0_, false, false); auto r1 = __builtin_amdgcn_permlane32_swap(a1, b1_, false, false); \
    u32x4 w = {r0[0], r1[0], r0[1], r1[1]}; OUT = *reinterpret_cast<bf16x8*>(&w); } while (0)
    PK4(p0, 0, pa0); PK4(p0, 8, pa1); PK4(p1, 0, pa2); PK4(p1, 8, pa3);
#undef PK4
}
__device__ __forceinline__ void mla_unit2(const Params& P, unsigned char* lds, int h, int rb, int grp, bool dry = false) {
    const int tid = opaque_tid(), lane = tid & 63, r32 = lane & 31, hi = lane >> 5; const int wid = __builtin_amdgcn_readfirstlane(tid >> 6);
    const int hoff = wid >> 2;
    unsigned char* ws = P.ws;
    const int l = grp ? 16384 : 2048; const size_t rowoff = grp ? M_A : 0; const int m0 = rb * 256; const int seq0 = m0 & ~(l - 1), t0 = m0 - seq0;
    const bf16_t* Qp = (const bf16_t*)(ws + WS_QG) + h * 96; const bf16_t* Kp = (const bf16_t*)(ws + WS_KG) + h * 64; const bf16_t* Vp = (const bf16_t*)(ws + WS_VG) + h * 64;
    const bf16_t* Kpe = (const bf16_t*)(ws + WS_KPE) + rowoff * 32; bf16_t* Gp = (bf16_t*)(ws + WS_U1) + rowoff * OD_INP + 416 + h * 64; const int ldg = OD_INP;
    const int NT = l >> 6;
    bf16x8 qr[6];
    { const bf16_t* Qw = Qp + (size_t)(seq0 + t0 + wid * 32 + r32) * 1536 + hi * 8;
#pragma unroll
      for (int d0 = 0; d0 < 6; ++d0) qr[d0] = *(const bf16x8*)(Qw + d0 * 16); }
    float* wsf = (float*)(lds + A_WS) + wid * 64; float* li_l = wsf; float* al_l = wsf + 32;
    float l_reg = 0.f, alpha = 1.f; f32x16 o[2] = {}; f32x16 p0, p1; bf16x8 pa0, pa1, pa2, pa3; f32x16 negm = {}; bool first = true;
    const int sr = tid >> 3, sc = (tid & 7) * 8, pr = (tid & 255) >> 2, pc = (tid & 3) * 8;
    const int vst = v_st(sr, sc);
    const int vb0 = (int)(uintptr_t)(lds + A_V0) + v_rd_base_kp(lane);
    const unsigned char* K0 = lds + A_K0; const unsigned char* K1 = lds + A_K0 + A_KBUF;
    unsigned char* kwE = lds + A_K0 + (hoff ? 0 : A_KBUF); unsigned char* vwE = lds + A_V0 + (hoff ? A_VBUF : 0);
    unsigned char* kwO = lds + A_K0 + (hoff ? A_KBUF : 0); unsigned char* vwO = lds + A_V0 + (hoff ? 0 : A_VBUF);
    bf16x8 ksE, vsE, psE, ksO, vsO, psO;
    const bf16_t* Kth = Kp + (size_t)(seq0 + sr) * 1024 + sc; const bf16_t* Vth = Vp + (size_t)(seq0 + sr) * 1024 + sc; const bf16_t* Pth = Kpe + (size_t)(seq0 + pr) * 32 + pc;
#define SLOAD(S, t) do { const int t_ = (t); if (t_ + 1 < NT) { ks##S = *(const bf16x8*)(Kth + (size_t)(t_ + 1) * 65536); ps##S = *(const bf16x8*)(Pth + (size_t)(t_ + 1) * 2048); } \
        if (t_ < NT) { vs##S = *(const bf16x8*)(Vth + (size_t)t_ * 65536); } } while (0)
#define SWRITE(S, t, kw, vw) do { const int t_ = (t); if (t_ + 1 < NT) { *(bf16x8*)((kw) + sr * KSTR + sc * 2) = ks##S; if (tid < 256) *(bf16x8*)((kw) + pr * KSTR + 128 + pc * 2) = ps##S; } \
        if (t_ < NT) *(bf16x8*)((vw) + vst) = vs##S; } while (0)
#define RESC(a) do { if (__any((a) < 1.f)) { if (hi == 0) al_l[r32] = (a); LDS_WAIT(); \
        _Pragma("unroll") for (int d = 0; d < 2; ++d) _Pragma("unroll") for (int r = 0; r < 16; ++r) o[d][r] *= al_l[crow(r, hi)]; LDS_WAIT(); } } while (0)
#define HBAR() do { asm volatile("s_waitcnt lgkmcnt(0)" ::: "memory"); __builtin_amdgcn_s_barrier(); asm volatile("" ::: "memory"); } while (0)
#define SBAR() __builtin_amdgcn_sched_barrier(0)
    { const bf16x8 k0v = *(const bf16x8*)(Kp + (size_t)(seq0 + sr) * 1024 + sc); const bf16x8 p0v = *(const bf16x8*)(Kpe + (size_t)(seq0 + pr) * 32 + pc);
      SLOAD(E, hoff); if (hoff) SLOAD(O, 0);
      *(bf16x8*)(lds + A_K0 + sr * KSTR + sc * 2) = k0v; if (tid < 256) *(bf16x8*)(lds + A_K0 + pr * KSTR + 128 + pc * 2) = p0v; }
    HBAR();
    if (hoff) { SWRITE(O, 0, kwO, vwO); HBAR(); }
    for (int i = 0; i < NT; i += 2) {
        SLOAD(O, i + 1 + hoff); SBAR();
        mla_qkt_neg(p0, p1, negm, K0, qr, r32, hi);
        if (i > 0) { pv_both_kp(o[0], o[1], vb0 + A_VBUF, pa0, pa1, pa2, pa3); }
        HBAR();
        __builtin_amdgcn_s_setprio(1);
        SWRITE(E, i + hoff, kwE, vwE); SBAR();
        mla_softmax_rel_kp(p0, p1, negm, first, l_reg, alpha, pa0, pa1, pa2, pa3); first = false; RESC(alpha);
        __builtin_amdgcn_s_setprio(0);
        HBAR();
        SLOAD(E, i + 2 + hoff); SBAR();
        mla_qkt_neg(p0, p1, negm, K1, qr, r32, hi);
        pv_both_kp(o[0], o[1], vb0, pa0, pa1, pa2, pa3);
        HBAR();
        __builtin_amdgcn_s_setprio(1);
        SWRITE(O, i + 1 + hoff, kwO, vwO); SBAR();
        mla_softmax_rel_kp(p0, p1, negm, first, l_reg, alpha, pa0, pa1, pa2, pa3); first = false; RESC(alpha);
        __builtin_amdgcn_s_setprio(0);
        HBAR();
    }
    if (dry) Gp = (bf16_t*)(ws + WS_END) + h * 64 - (size_t)(seq0 + t0) * ldg + (size_t)((rb & 7) * 256) * ldg;
    bf16_t* Gw = Gp + (size_t)(seq0 + t0 + wid * 32) * ldg + r32;
    bf16_t gq[32];
#pragma unroll
    for (int r = 0; r < 16; ++r) { const int orow = crow(r, hi); gq[2 * r] = Gw[(size_t)orow * ldg]; gq[2 * r + 1] = Gw[(size_t)orow * ldg + 32]; }
    pv_both_kp(o[0], o[1], vb0 + A_VBUF, pa0, pa1, pa2, pa3);
    HBAR();
    if (!hoff) HBAR();
#undef SLOAD
#undef SWRITE
#undef RESC
#undef HBAR
#undef SBAR
    if (hi == 0) li_l[r32] = l_reg; LDS_WAIT();
    float rli[16];
#pragma unroll
    for (int r = 0; r < 16; ++r) rli[r] = __builtin_amdgcn_rcpf(li_l[crow(r, hi)]);
#pragma unroll
    for (int r = 0; r < 16; ++r) { const int orow = crow(r, hi);
#pragma unroll
        for (int d0 = 0; d0 < 2; ++d0) { bf16_t* gp = Gw + (size_t)orow * ldg + d0 * 32; const float g = bf2f(gq[2 * r + d0]);
            const float sg = g * __builtin_amdgcn_rcpf(1.f + __builtin_amdgcn_exp2f(-g * LOG2E));
            *gp = (bf16_t)(cvt_pk_bf16(o[d0][r] * rli[r] * sg, 0.f) & 0xffffu); } }
    LDS_WAIT();
}

__device__ __forceinline__ void transpose_tile(const float* W, int K, int N, bf16_t* WT, LAS float* scr, int k0, int n0, int lane, const float* kscale, float cscale) {
#pragma unroll 8
    for (int i = 0; i < 32; ++i) { const int kk = 2 * i + (lane >> 5); float s = cscale; if (kscale) s *= kscale[k0 + kk];
        scr[kk * 33 + (lane & 31)] = W[(size_t)(k0 + kk) * N + n0 + (lane & 31)] * s; }
    LDS_WAIT(); asm volatile("" ::: "memory");
    const int c = lane & 7;
#pragma unroll
    for (int j = 0; j < 4; ++j) { const int n = (lane >> 3) + 8 * j; const LAS float* s = scr + (8 * c) * 33 + n;
        u32x4 o; o.x = cvt_pk_bf16(s[0 * 33], s[1 * 33]); o.y = cvt_pk_bf16(s[2 * 33], s[3 * 33]); o.z = cvt_pk_bf16(s[4 * 33], s[5 * 33]); o.w = cvt_pk_bf16(s[6 * 33], s[7 * 33]);
        *(u32x4*)(WT + (size_t)(n0 + n) * K + k0 + 8 * c) = o; }
    LDS_WAIT(); asm volatile("" ::: "memory");
}

__device__ __forceinline__ void phase0(const Params& P, unsigned char* lds) {
    const int tid = opaque_tid(), lane = tid & 63, wave = tid >> 6, G = gridDim.x;
    const int gw = blockIdx.x * 8 + wave, NGW = G * 8, gtid = blockIdx.x * 512 + tid, NTH = G * 512;
    unsigned char* ws = P.ws;
    { float2* rope = (float2*)(ws + WS_ROPE);
      for (int i = gtid; i < 16384 * 16; i += NTH) { const int pos = i >> 4, j = i & 15;
          const float invf = (float)exp2(-(double)j * (13.287712379549449 / 16.0)); const float ang = (float)pos * invf;
          double rev = (double)ang * 0.15915494309189535; rev -= floor(rev); const float rv = (float)rev;
          rope[i] = make_float2(__builtin_amdgcn_cosf(rv), __builtin_amdgcn_sinf(rv)); } }
    { u32x4* z = (u32x4*)((bf16_t*)(ws + WS_WIN1) + (size_t)OD_IN * DM); const int n16 = (OD_INP - OD_IN) * DM * 2 / 16;
      for (int i = gtid; i < n16; i += NTH) z[i] = (u32x4){0u, 0u, 0u, 0u}; }
    { LAS float* scr = (LAS float*)(LAS unsigned char*)lds + wave * (64 * 33);
      constexpr int I0 = 16 * 104, I1 = 16 * 32, I2 = 16 * 45, I3 = 4 * 48, I4 = 2 * 64, I5 = 16 * 32, NIT = I0 + I1 + I2 + I3 + I4 + I5;
      for (int it = gw; it < NIT; it += NGW) { int r = it;
          if (r < I0) { const int kb = r / 104, nb = r % 104, n0 = nb * 32; const float cs = (n0 < 512 || (n0 >= 1536 && n0 < 2048)) ? QS64 : 1.f;
              transpose_tile(P.ev_w_in, 1024, EV_IN, (bf16_t*)(ws + WS_WIN0), scr, kb * 64, n0, lane, nullptr, cs); continue; } r -= I0;
          if (r < I1) { transpose_tile(P.ev_w_out, 1024, 1024, (bf16_t*)(ws + WS_WOUT0), scr, (r / 32) * 64, (r % 32) * 32, lane, nullptr, 1.f); continue; } r -= I1;
          if (r < I2) { transpose_tile(P.mla_w_in, 1024, OD_IN, (bf16_t*)(ws + WS_WIN1), scr, (r / 45) * 64, (r % 45) * 32, lane, nullptr, 1.f); continue; } r -= I2;
          if (r < I3) { transpose_tile(P.mla_w_qb, 256, 1536, (bf16_t*)(ws + WS_WQB), scr, (r / 48) * 64, (r % 48) * 32, lane, P.mla_q_norm, 1.f); continue; } r -= I3;
          if (r < I4) { transpose_tile(P.mla_w_kvb, 128, 2048, (bf16_t*)(ws + WS_WKVB), scr, (r / 64) * 64, (r % 64) * 32, lane, P.mla_kv_norm, 1.f); continue; } r -= I4;
          transpose_tile(P.mla_w_out, 1024, 1024, (bf16_t*)(ws + WS_WOUT1), scr, (r / 32) * 64, (r % 32) * 32, lane, nullptr, 1.f); } }
    __syncthreads();
    { float* cs = (float*)lds; float* mod = (float*)(ws + WS_MOD);
      for (int u = blockIdx.x; u < 192; u += G) { const int cc = u % 12, kc = u / 12; const int col = cc * 512 + tid, layer = col / 3072, n = col % 3072;
          __syncthreads();
          for (int i = tid; i < 18 * 64; i += 512) { const int bi = i >> 6, k = kc * 64 + (i & 63); const float c = bi < 16 ? P.c_p[bi * DM + k] : P.c_s[(bi - 16) * DM + k];
              cs[i] = c / (1.f + __expf(-c)); }
          __syncthreads();
          float acc[18];
#pragma unroll
          for (int b = 0; b < 18; ++b) acc[b] = 0.f;
          const float* w = P.ada_w + ((size_t)layer * 1024 + kc * 64) * 3072 + n;
          for (int k0 = 0; k0 < 64; k0 += 8) { float wv[8];
#pragma unroll
              for (int kk = 0; kk < 8; ++kk) wv[kk] = w[(size_t)(k0 + kk) * 3072];
#pragma unroll
              for (int kk = 0; kk < 8; ++kk)
#pragma unroll
                  for (int b = 0; b < 18; ++b) acc[b] += cs[b * 64 + k0 + kk] * wv[kk]; }
          const float bias = (kc == 0) ? P.ada_b[layer * 3072 + n] : 0.f;
#pragma unroll
          for (int b = 0; b < 18; ++b) atomicAdd(mod + (size_t)(b * 2 + layer) * 3072 + n, acc[b] + bias); }
      __syncthreads(); }
}

__device__ __forceinline__ void norm_mod_phase(const Params& P, int layer, bool from_out, bf16_t* H) {
    const int tid = opaque_tid(), lane = tid & 63, wave = tid >> 6; const int gw = blockIdx.x * 8 + wave, NGW = gridDim.x * 8;
    const float* modbuf = (const float*)(P.ws + WS_MOD); const float* gn = P.norm_g + layer * DM;
    for (int m = gw; m < M_TOK; m += 2 * NGW) {
        const int m2 = m + NGW;
        const bool has2 = m2 < M_TOK; const int mb = has2 ? m2 : m;
        const float* xa = from_out ? P.out + (size_t)m * DM : (m < M_A ? P.x_p + (size_t)m * DM : P.x_s + (size_t)(m - M_A) * DM);
        const float* xb = from_out ? P.out + (size_t)mb * DM : (mb < M_A ? P.x_p + (size_t)mb * DM : P.x_s + (size_t)(mb - M_A) * DM);
        f32x4 va[4], vb[4]; float sa = 0.f, sb = 0.f;
#pragma unroll
        for (int j = 0; j < 4; ++j) { va[j] = *(const f32x4*)(xa + 4 * lane + 256 * j); vb[j] = *(const f32x4*)(xb + 4 * lane + 256 * j); }
#pragma unroll
        for (int j = 0; j < 4; ++j) { sa += (va[j][0] * va[j][0] + va[j][1] * va[j][1]) + (va[j][2] * va[j][2] + va[j][3] * va[j][3]);
                                      sb += (vb[j][0] * vb[j][0] + vb[j][1] * vb[j][1]) + (vb[j][2] * vb[j][2] + vb[j][3] * vb[j][3]); }
        const float ra = rsqrtf(wave_sum(sa) * (1.0f / DM) + EPS), rb = rsqrtf(wave_sum(sb) * (1.0f / DM) + EPS);
        const float* moda = modbuf + (size_t)(batch_of_row(m) * 2 + layer) * 3072; const float* modb = modbuf + (size_t)(batch_of_row(mb) * 2 + layer) * 3072;
#pragma unroll
        for (int j = 0; j < 4; ++j) { const int c = 4 * lane + 256 * j; const f32x4 g = *(const f32x4*)(gn + c);
            { const f32x4 sh = *(const f32x4*)(moda + c), sc = *(const f32x4*)(moda + 1024 + c); const f32x4 hv = va[j] * ra * g * (sc + 1.0f) + sh;
              u32x2 w; w.x = cvt_pk_bf16(hv[0], hv[1]); w.y = cvt_pk_bf16(hv[2], hv[3]); *(u32x2*)(H + (size_t)m * DM + c) = w; }
            if (has2) { const f32x4 sh = *(const f32x4*)(modb + c), sc = *(const f32x4*)(modb + 1024 + c); const f32x4 hv = vb[j] * rb * g * (sc + 1.0f) + sh;
              u32x2 w; w.x = cvt_pk_bf16(hv[0], hv[1]); w.y = cvt_pk_bf16(hv[2], hv[3]); *(u32x2*)(H + (size_t)m2 * DM + c) = w; } }
    }
}
__device__ __forceinline__ void final_norm_phase(const Params& P) {
    const int tid = opaque_tid(), lane = tid & 63, wave = tid >> 6; const int gw = blockIdx.x * 8 + wave, NGW = gridDim.x * 8;
    for (int m = gw; m < M_TOK; m += 2 * NGW) {
        const int m2 = m + NGW; const bool has2 = m2 < M_TOK; const int mb = has2 ? m2 : m;
        float* xa = P.out + (size_t)m * DM; float* xb = P.out + (size_t)mb * DM;
        f32x4 va[4], vb[4]; float sa = 0.f, sb = 0.f;
#pragma unroll
        for (int j = 0; j < 4; ++j) { va[j] = *(const f32x4*)(xa + 4 * lane + 256 * j); vb[j] = *(const f32x4*)(xb + 4 * lane + 256 * j); }
#pragma unroll
        for (int j = 0; j < 4; ++j) { sa += (va[j][0] * va[j][0] + va[j][1] * va[j][1]) + (va[j][2] * va[j][2] + va[j][3] * va[j][3]);
                                      sb += (vb[j][0] * vb[j][0] + vb[j][1] * vb[j][1]) + (vb[j][2] * vb[j][2] + vb[j][3] * vb[j][3]); }
        const float ra = rsqrtf(wave_sum(sa) * (1.0f / DM) + EPS), rb = rsqrtf(wave_sum(sb) * (1.0f / DM) + EPS);
#pragma unroll
        for (int j = 0; j < 4; ++j) { const int c = 4 * lane + 256 * j; const f32x4 g = *(const f32x4*)(P.final_g + c);
            *(f32x4*)(xa + c) = va[j] * ra * g; if (has2) *(f32x4*)(xb + c) = vb[j] * rb * g; }
    }
}

__global__ void __launch_bounds__(512, 2) mega_fwd(Params Pk) {
    extern __shared__ __attribute__((aligned(16))) unsigned char lds[];
    cg::grid_group grid = cg::this_grid();
    LAS unsigned char* ldsl = (LAS unsigned char*)lds;
    const int G = gridDim.x, bx = blockIdx.x;
    typedef const __attribute__((address_space(4))) Params* KP;
#if defined(__HIP_DEVICE_COMPILE__)
#define PHASE_LOADP() KP kp_ = (KP)__builtin_amdgcn_kernarg_segment_ptr(); asm volatile("" : "+s"(kp_)); Params P; __builtin_memcpy(&P, kp_, sizeof(Params))
#else
#define PHASE_LOADP() const Params P = Pk
#endif
#define PHASE_ARGS() PHASE_LOADP(); unsigned char* ws = P.ws; \
    const float* modbuf = (const float*)(ws + WS_MOD); const float2* rope = (const float2*)(ws + WS_ROPE); (void)modbuf; (void)rope

    volatile LAS unsigned* bst = (volatile LAS unsigned*)(ldsl + 132096);
    if (threadIdx.x < 4) bst[threadIdx.x] = 0u;
    __syncthreads();
    { PHASE_ARGS(); (void)xcd_barrier_post((unsigned*)(ws + WS_BAR), bst); }
#define GRID_BAR() do { PHASE_ARGS(); XcdBarrier xb_; xb_.bar = (unsigned*)(ws + WS_BAR); xb_.x = xb_xcc_id(); xb_.st = (volatile LAS unsigned*)(ldsl + 132096); xcd_barrier(xb_); } while (0)
    { PHASE_ARGS(); phase0(P, lds); }
    grid.sync();
    { PHASE_ARGS(); norm_mod_phase(P, 0, false, (bf16_t*)P.out); }
    GRID_BAR();
    { PHASE_ARGS(); pg8::Gemm g{(const bf16_t*)P.out, (const bf16_t*)(ws + WS_WIN0), M_TOK, EV_IN, DM, DM}; pg8::StaticOrder S; S.init(M_TOK, EV_IN, G, bx);
      pg8::EpiBf16 E{(bf16_t*)(ws + WS_U0), EV_IN};
      pg8::gemm_phase<pg8::EpiBf16, pg8::StaticOrder, true, true>(ldsl, g, S, E); }
    GRID_BAR();
    for (int u = bx; u < 4096; u += G) { PHASE_ARGS(); if (u < 2048) attn_unit<0>(P, lds, u >> 8, u & 255, 0); else attn_unit<1>(P, lds, (u - 2048) >> 8, u & 255, 0); }
    GRID_BAR();
    { PHASE_ARGS(); pg8::Gemm g{(const bf16_t*)(ws + WS_U0) + 2304, (const bf16_t*)(ws + WS_WOUT0), M_TOK, DM, DM, EV_IN}; pg8::StaticOrder S; S.init(M_TOK, DM, G, bx);
      pg8::EpiGateRes E{P.x_p, P.x_s, P.out, modbuf, 0, 0};
      pg8::gemm_phase<pg8::EpiGateRes, pg8::StaticOrder, true, true>(ldsl, g, S, E); }
    GRID_BAR();
    { PHASE_ARGS(); norm_mod_phase(P, 1, true, (bf16_t*)(ws + WS_H1)); }
    GRID_BAR();
    { PHASE_ARGS(); pg8::Gemm g{(const bf16_t*)(ws + WS_H1), (const bf16_t*)(ws + WS_WIN1), M_TOK, OD_INP, DM, DM}; pg8::StaticOrder S; S.init(M_TOK, OD_INP, G, bx);
      pg8::EpiU1 E{(bf16_t*)(ws + WS_U1), (float*)(ws + WS_SSQQ), (float*)(ws + WS_SSQKV), (bf16_t*)(ws + WS_KPE), rope};
      pg8::gemm_phase<pg8::EpiU1, pg8::StaticOrder, true, true>(ldsl, g, S, E); }
    GRID_BAR();
    for (int grp = 0; grp < 2; ++grp) {
        const int row_off = grp * M_A;
        { PHASE_ARGS(); pg8::Gemm g{(const bf16_t*)(ws + WS_U1) + (size_t)row_off * OD_INP, (const bf16_t*)(ws + WS_WQB), M_A, 1536, 256, OD_INP}; pg8::StaticOrder S; S.init(M_A, 1536, G, bx);
          pg8::EpiQ E{(bf16_t*)(ws + WS_QG), (const float*)(ws + WS_SSQQ), rope, row_off};
          pg8::gemm_phase<pg8::EpiQ, pg8::StaticOrder, true, true>(ldsl, g, S, E); }
        { PHASE_ARGS(); pg8::Gemm g{(const bf16_t*)(ws + WS_U1) + (size_t)row_off * OD_INP + 256, (const bf16_t*)(ws + WS_WKVB), M_A, 2048, 128, OD_INP}; pg8::StaticOrder S; S.init(M_A, 2048, G, bx);
          pg8::EpiKV E{(bf16_t*)(ws + WS_KG), (bf16_t*)(ws + WS_VG), (const float*)(ws + WS_SSQKV), row_off};
          pg8::gemm_phase<pg8::EpiKV, pg8::StaticOrder, true, true>(ldsl, g, S, E); }
        GRID_BAR();
        for (int u = bx; u < 2048; u += G) { PHASE_ARGS(); mla_unit2(P, lds, u >> 7, u & 127, grp); }
        GRID_BAR();
    }
    { PHASE_ARGS(); pg8::Gemm g{(const bf16_t*)(ws + WS_U1) + 416, (const bf16_t*)(ws + WS_WOUT1), M_TOK, DM, DM, OD_INP}; pg8::StaticOrder S; S.init(M_TOK, DM, G, bx);
      pg8::EpiGateRes E{P.x_p, P.x_s, P.out, modbuf, 1, 1};
      pg8::gemm_phase<pg8::EpiGateRes, pg8::StaticOrder, true, true>(ldsl, g, S, E); }
    GRID_BAR();
    { PHASE_ARGS(); final_norm_phase(P); }
}

extern "C" void kernel_launch(void* const* d_in, const int* in_sizes, int n_in, void* d_out, int out_size, void* d_ws, size_t ws_size, hipStream_t stream) {
    static int grid = 0;
    if (grid == 0) {
        if (n_in != 19 || out_size != 2 * M_A * DM || ws_size < WS_END) { fprintf(stderr, "kernel_launch: unexpected shapes (n_in %d out %d ws %zu)\n", n_in, out_size, ws_size); grid = -1; return; }
        int dev = 0, cus = 0, per_cu = 0;
        hipGetDevice(&dev); hipDeviceGetAttribute(&cus, hipDeviceAttributeMultiprocessorCount, dev);
        if (hipFuncSetAttribute((const void*)mega_fwd, hipFuncAttributeMaxDynamicSharedMemorySize, LDS_BYTES) != hipSuccess) { fprintf(stderr, "kernel_launch: hipFuncSetAttribute failed\n"); grid = -1; return; }
        if (hipOccupancyMaxActiveBlocksPerMultiprocessor(&per_cu, (const void*)mega_fwd, 512, LDS_BYTES) != hipSuccess || per_cu < 1) { fprintf(stderr, "kernel_launch: occupancy query gave %d\n", per_cu); per_cu = 1; }
        (void)hipGetLastError();
        grid = cus * 1;
    }
    if (grid < 0) return;
    hipMemsetAsync(d_ws, 0, WS_ZERO_BYTES, stream);
    Params p{};
    p.x_p = (const float*)d_in[0]; p.x_s = (const float*)d_in[1]; p.c_p = (const float*)d_in[2]; p.c_s = (const float*)d_in[3];
    p.ada_w = (const float*)d_in[4]; p.ada_b = (const float*)d_in[5]; p.norm_g = (const float*)d_in[6]; p.t5_bias = (const float*)d_in[7];
    p.ev_w_in = (const float*)d_in[8]; p.na_rpb = (const float*)d_in[9]; p.wb_sink = (const float*)d_in[10]; p.ev_w_out = (const float*)d_in[11];
    p.mla_w_in = (const float*)d_in[12]; p.mla_q_norm = (const float*)d_in[13]; p.mla_w_qb = (const float*)d_in[14]; p.mla_kv_norm = (const float*)d_in[15];
    p.mla_w_kvb = (const float*)d_in[16]; p.mla_w_out = (const float*)d_in[17]; p.final_g = (const float*)d_in[18];
    p.out = (float*)d_out; p.ws = (unsigned char*)d_ws;
    void* args[] = {&p};
    hipError_t e = hipLaunchCooperativeKernel((const void*)mega_fwd, dim3(grid), dim3(512), args, LDS_BYTES, stream);
    if (e != hipSuccess) fprintf(stderr, "kernel_launch: cooperative launch failed: %s (grid %d)\n", hipGetErrorString(e), grid);
}
```
